# Optimizing an MI355X kernel written in HIP

```python
import functools
import jax, jax.numpy as jnp
from jax import lax
import numpy as np

D_MODEL = 1024
BATCH = 1
SEQ = 16384
DEPTH = 1
DEC_BATCH = 32
DEC_SEQ = 1
PAST_LEN = 16384
PAGE_SIZE = 128

HEAD_DIM = 64
HEADS_PER_GROUP = 8
GROUPS = ((128, 1), (512, 4), (2048, 16))
N_GROUPS = len(GROUPS)
ATTN_HEADS = N_GROUPS * HEADS_PER_GROUP
QKV_WIDTH = ATTN_HEADS * HEAD_DIM
ATTN_OUT = HEADS_PER_GROUP * HEAD_DIM
BLOCK = 128
ATTN_SCALE = HEAD_DIM ** -0.5
NEG_INF = -1e30
D_RNN = 1280
RNN_BLOCKS = 10
RNN_BLOCK_W = D_RNN // RNN_BLOCKS
CONV_W = 4
LRU_C = 8.0
D_FF = -(-8 * D_MODEL // (3 * 256)) * 256
RMS_EPS = 1e-6

IN_WIDTHS = (QKV_WIDTH, QKV_WIDTH, QKV_WIDTH, D_RNN, D_RNN, D_MODEL, D_MODEL)
IN_WIDTH = sum(IN_WIDTHS)
SPLIT_POINTS = tuple(int(c) for c in np.cumsum(IN_WIDTHS)[:-1])

kernel_name = "hybrid_dilated_swa_rglru_decode_step"


def rms_norm(x, g):
    xf = x.astype(jnp.float32)
    y = xf * lax.rsqrt(jnp.mean(xf * xf, axis=-1, keepdims=True) + RMS_EPS)
    return (y * g.astype(jnp.float32)).astype(x.dtype)


def dilated_group_prompt(q, k, v, window, dilation):
    b, s, h, dh = q.shape
    span = window // dilation
    unit = dilation * BLOCK
    sp = -(-s // unit) * unit
    m_len = sp // dilation
    nb = m_len // BLOCK

    def to_blocks(t):
        t = jnp.pad(t, ((0, 0), (0, sp - s), (0, 0), (0, 0)))
        t = t.reshape(b, m_len, dilation, h, dh).transpose(0, 2, 1, 3, 4)
        return t.reshape(b * dilation, nb, BLOCK, h, dh)

    def with_prev(t):
        prev = jnp.pad(t[:, :-1], ((0, 0), (1, 0), (0, 0), (0, 0), (0, 0)))
        return jnp.concatenate([prev, t], axis=2)

    def from_blocks(t):
        t = t.reshape((b, dilation, m_len) + t.shape[3:])
        t = jnp.swapaxes(t, 1, 2).reshape((b, sp) + t.shape[3:])
        return t[:, :s]

    qb = to_blocks(q)
    kc = with_prev(to_blocks(k))
    vc = with_prev(to_blocks(v))
    qi = jnp.arange(BLOCK)[:, None]
    kj = jnp.arange(2 * BLOCK)[None, :]
    dist = BLOCK + qi - kj
    blk = jnp.arange(nb)[:, None, None]
    valid = (dist >= 0) & (dist <= span) & ((blk > 0) | (kj >= BLOCK))
    scores = jnp.einsum('nbqhd,nbkhd->nbhqk', qb, kc,
                        preferred_element_type=jnp.float32) * ATTN_SCALE
    scores = jnp.where(valid[None, :, None], scores, NEG_INF)
    mx = jnp.max(scores, axis=-1)
    p = jnp.exp(scores - mx[..., None])
    den = jnp.sum(p, axis=-1)
    numer = jnp.einsum('nbhqk,nbkhd->nbqhd', p, vc.astype(jnp.float32))
    return (from_blocks(numer), from_blocks(jnp.swapaxes(mx, 2, 3)),
            from_blocks(jnp.swapaxes(den, 2, 3)))


def dilated_group_sample(q, k_full, v_full, past_rows, window, dilation):
    t = q.shape[1]
    span = window // dilation
    idx = past_rows + jnp.arange(t)[:, None] - dilation * jnp.arange(span + 1)[None, :]
    valid = idx >= 0
    idx = jnp.maximum(idx, 0)
    kg = k_full[:, idx]
    vg = v_full[:, idx]
    scores = jnp.einsum('bthd,btjhd->bthj', q, kg,
                        preferred_element_type=jnp.float32) * ATTN_SCALE
    scores = jnp.where(valid[None, :, None, :], scores, NEG_INF)
    mx = jnp.max(scores, axis=-1)
    p = jnp.exp(scores - mx[..., None])
    den = jnp.sum(p, axis=-1)
    numer = jnp.einsum('bthj,btjhd->bthd', p, vg.astype(jnp.float32))
    return numer, mx, den


def combine_groups(parts):
    numers, maxes, dens = zip(*parts)
    m_all = jnp.max(jnp.stack(maxes), axis=0)
    w = [jnp.exp(m - m_all) for m in maxes]
    num = sum(n * wi[..., None] for n, wi in zip(numers, w))
    den = sum(d * wi for d, wi in zip(dens, w))
    return num / den[..., None]


def group_slice(t, g):
    return t[:, :, g * HEADS_PER_GROUP:(g + 1) * HEADS_PER_GROUP]


def prompt_attention(q, k, v):
    parts, rows = [], []
    s = q.shape[1]
    for g, (window, dilation) in enumerate(GROUPS):
        qg, kg, vg = group_slice(q, g), group_slice(k, g), group_slice(v, g)
        parts.append(dilated_group_prompt(qg, kg, vg, window, dilation))
        keep = min(window, s)
        rows.append(jnp.stack([kg[:, s - keep:], vg[:, s - keep:]], axis=2))
    return combine_groups(parts), rows


def sample_attention(q, k, v, caches):
    parts, rows = [], []
    for g, (window, dilation) in enumerate(GROUPS):
        qg, kg, vg = group_slice(q, g), group_slice(k, g), group_slice(v, g)
        cache = caches[g]
        past_rows = cache.shape[1]
        k_full = jnp.concatenate([cache[:, :, 0].astype(kg.dtype), kg], axis=1)
        v_full = jnp.concatenate([cache[:, :, 1].astype(vg.dtype), vg], axis=1)
        parts.append(dilated_group_sample(qg, k_full, v_full, past_rows, window, dilation))
        rows.append(jnp.stack([kg, vg], axis=2))
    return combine_groups(parts), rows


def linear_recurrence(a, b, h0):
    b = b.at[:, 0].add(a[:, 0] * h0)

    def combine(left, right):
        a_l, b_l = left
        a_r, b_r = right
        return a_l * a_r, a_r * b_l + b_r

    _, h = lax.associative_scan(combine, (a, b), axis=1)
    return h


def hybrid_layer(x, attention, conv_buf, h0, norm1_g, w_in, b_gate, q_norm_g, k_norm_g,
                 conv_w, conv_b, w_rg, b_rg, w_ig, b_ig, lru_lambda, w_o_attn, w_o_rnn,
                 w_out, norm2_g, w_ffn_in, w_ffn_out):
    bsz, t, _ = x.shape
    hn = rms_norm(x, norm1_g)
    q, k, v, xb, gb, gate_a, gate_b = jnp.split(hn @ w_in, SPLIT_POINTS, axis=-1)
    q = rms_norm(q.reshape(bsz, t, ATTN_HEADS, HEAD_DIM), q_norm_g)
    k = rms_norm(k.reshape(bsz, t, ATTN_HEADS, HEAD_DIM), k_norm_g)
    v = v.reshape(bsz, t, ATTN_HEADS, HEAD_DIM)
    attn, kv_rows = attention(q, k, v)
    y_a = attn.reshape(bsz, t, ATTN_OUT).astype(x.dtype) @ w_o_attn
    xpad = jnp.concatenate([conv_buf.astype(xb.dtype), xb], axis=1)
    xc = sum(xpad[:, j:j + t] * conv_w[j] for j in range(CONV_W)) + conv_b
    new_conv = xpad[:, t:]
    xblk = xc.reshape(bsz, t, RNN_BLOCKS, RNN_BLOCK_W)
    r = jax.nn.sigmoid((jnp.einsum('btnc,ncd->btnd', xblk, w_rg).reshape(bsz, t, D_RNN)
                        + b_rg).astype(jnp.float32))
    i = jax.nn.sigmoid((jnp.einsum('btnc,ncd->btnd', xblk, w_ig).reshape(bsz, t, D_RNN)
                        + b_ig).astype(jnp.float32))
    log_a = -LRU_C * r * jax.nn.softplus(-lru_lambda.astype(jnp.float32))
    a = jnp.exp(log_a)
    b_in = jnp.sqrt(-jnp.expm1(2.0 * log_a)) * i * xc.astype(jnp.float32)
    h = linear_recurrence(a, b_in, h0.astype(jnp.float32))
    h_last = h[:, -1]
    y_b = (h * jax.nn.gelu(gb.astype(jnp.float32))).astype(x.dtype) @ w_o_rnn
    merged = jax.nn.sigmoid(gate_a + b_gate[0]) * y_a + jax.nn.sigmoid(gate_b + b_gate[1]) * y_b
    x = x + merged @ w_out
    g, u = jnp.split(rms_norm(x, norm2_g) @ w_ffn_in, 2, axis=-1)
    x = x + (jax.nn.silu(g) * u) @ w_ffn_out
    return x, kv_rows, new_conv, h_last


def setup_inputs(seed: int = 0) -> dict:
    key = jax.random.key(seed)
    ks = jax.random.split(key, 32)
    f32 = jnp.float32
    nrm = lambda k, shape: jax.random.normal(k, shape, f32)
    x_prompt = nrm(ks[0], (BATCH, SEQ, D_MODEL))
    x_sample = nrm(ks[1], (DEC_BATCH, DEC_SEQ, D_MODEL))
    caches = [nrm(ks[2 + g], (DEPTH, DEC_BATCH, min(w, PAST_LEN), 2, HEADS_PER_GROUP, HEAD_DIM))
              for g, (w, _) in enumerate(GROUPS)]
    state_conv = nrm(ks[5], (DEPTH, DEC_BATCH, CONV_W - 1, D_RNN))
    state_h = 0.5 * nrm(ks[6], (DEPTH, DEC_BATCH, D_RNN))
    a0 = jax.random.uniform(ks[7], (DEPTH, D_RNN), f32, 0.9, 0.999) ** (1.0 / LRU_C)
    lru_lambda = jnp.log(a0) - jnp.log1p(-a0)
    return {
        "x_prompt": x_prompt,
        "x_sample": x_sample,
        "cache_kv_w128": caches[0],
        "cache_kv_w512": caches[1],
        "cache_kv_w2048": caches[2],
        "state_conv": state_conv,
        "state_h": state_h,
        "norm1_g": 1.0 + 0.02 * nrm(ks[8], (DEPTH, D_MODEL)),
        "w_in": nrm(ks[9], (DEPTH, D_MODEL, IN_WIDTH)) * D_MODEL ** -0.5,
        "b_gate": 0.02 * nrm(ks[10], (DEPTH, 2, D_MODEL)),
        "q_norm_g": 1.0 + 0.02 * nrm(ks[11], (DEPTH, HEAD_DIM)),
        "k_norm_g": 1.0 + 0.02 * nrm(ks[12], (DEPTH, HEAD_DIM)),
        "conv_w": nrm(ks[13], (DEPTH, CONV_W, D_RNN)) * CONV_W ** -0.5,
        "conv_b": 0.02 * nrm(ks[14], (DEPTH, D_RNN)),
        "w_rg": nrm(ks[15], (DEPTH, RNN_BLOCKS, RNN_BLOCK_W, RNN_BLOCK_W)) * RNN_BLOCK_W ** -0.5,
        "b_rg": 0.02 * nrm(ks[16], (DEPTH, D_RNN)),
        "w_ig": nrm(ks[17], (DEPTH, RNN_BLOCKS, RNN_BLOCK_W, RNN_BLOCK_W)) * RNN_BLOCK_W ** -0.5,
        "b_ig": 0.02 * nrm(ks[18], (DEPTH, D_RNN)),
        "lru_lambda": lru_lambda,
        "w_o_attn": nrm(ks[19], (DEPTH, ATTN_OUT, D_MODEL)) * ATTN_OUT ** -0.5,
        "w_o_rnn": nrm(ks[20], (DEPTH, D_RNN, D_MODEL)) * D_RNN ** -0.5,
        "w_out": nrm(ks[21], (DEPTH, D_MODEL, D_MODEL)) * D_MODEL ** -0.5,
        "norm2_g": 1.0 + 0.02 * nrm(ks[22], (DEPTH, D_MODEL)),
        "w_ffn_in": nrm(ks[23], (DEPTH, D_MODEL, 2 * D_FF)) * D_MODEL ** -0.5,
        "w_ffn_out": nrm(ks[24], (DEPTH, D_FF, D_MODEL)) * D_FF ** -0.5,
    }


def reference(x_prompt, x_sample, cache_kv_w128, cache_kv_w512, cache_kv_w2048, state_conv,
              state_h, norm1_g, w_in, b_gate, q_norm_g, k_norm_g, conv_w, conv_b, w_rg, b_rg,
              w_ig, b_ig, lru_lambda, w_o_attn, w_o_rnn, w_out, norm2_g, w_ffn_in, w_ffn_out):
    y_p, y_s = x_prompt, x_sample
    kvp, kvs = [[], [], []], [[], [], []]
    conv_p, conv_s, h_p, h_s = [], [], [], []
    for layer in range(DEPTH):
        weights = (norm1_g[layer], w_in[layer], b_gate[layer], q_norm_g[layer], k_norm_g[layer],
                   conv_w[layer], conv_b[layer], w_rg[layer], b_rg[layer], w_ig[layer],
                   b_ig[layer], lru_lambda[layer], w_o_attn[layer], w_o_rnn[layer],
                   w_out[layer], norm2_g[layer], w_ffn_in[layer], w_ffn_out[layer])
        zero_conv = jnp.zeros((y_p.shape[0], CONV_W - 1, D_RNN), y_p.dtype)
        zero_h = jnp.zeros((y_p.shape[0], D_RNN), jnp.float32)
        y_p, rows_p, c_p, hl_p = hybrid_layer(y_p, prompt_attention, zero_conv, zero_h, *weights)
        sample_attn = functools.partial(
            sample_attention,
            caches=(cache_kv_w128[layer], cache_kv_w512[layer], cache_kv_w2048[layer]))
        y_s, rows_s, c_s, hl_s = hybrid_layer(y_s, sample_attn, state_conv[layer],
                                              state_h[layer], *weights)
        for g in range(N_GROUPS):
            kvp[g].append(rows_p[g])
            kvs[g].append(rows_s[g])
        conv_p.append(c_p)
        conv_s.append(c_s)
        h_p.append(hl_p)
        h_s.append(hl_s)
    return (y_p, y_s,
            jnp.stack(kvp[0]), jnp.stack(kvp[1]), jnp.stack(kvp[2]),
            jnp.stack(conv_p), jnp.stack(h_p),
            jnp.stack(kvs[0]), jnp.stack(kvs[1]), jnp.stack(kvs[2]),
            jnp.stack(conv_s), jnp.stack(h_s))
```

```cpp
#include <hip/hip_runtime.h>
#include <hip/hip_cooperative_groups.h>
#include <cstdio>
#include <cstdint>
namespace cg = cooperative_groups;

#ifndef MK_MULTI
#define MK_MULTI 0
#endif


constexpr int S_ = 16384, DM_ = 1024, NBS = 32, QKV_ = 1536, DR_ = 1280, DFF_ = 2816, INW_ = 9216;
constexpr float RMS_EPS_ = 1e-6f, LOG2E_ = 1.4426950408889634f, QSCALE_ = 0.125f * 1.4426950408889634f;
constexpr size_t O_YP = 0, O_YS = 16777216, O_KVP0 = 16809984, O_KVP1 = 16941056, O_KVP2 = 17465344, O_CONVP = 19562496, O_HP = 19566336,
                 O_KVS0 = 19567616, O_KVS1 = 19600384, O_KVS2 = 19633152, O_CONVS = 19665920, O_HS = 19788800, O_END = 19829760;
constexpr size_t MiB_ = 1u << 20;
constexpr size_t WS_WIN = 0, WS_WG = 18 * MiB_, WS_WOA = 19 * MiB_, WS_WOB = 20 * MiB_, WS_WOUT = 23 * MiB_, WS_WFF1 = 25 * MiB_, WS_WFF2 = 36 * MiB_, WS_SMALL = 42 * MiB_,
                 WS_HN = 48 * MiB_, WS_Q = 81 * MiB_, WS_K = 129 * MiB_, WS_V = 177 * MiB_, WS_XB = 225 * MiB_, WS_GG = 265 * MiB_, WS_SA = 305 * MiB_, WS_SB = 337 * MiB_,
                 WS_OG = 369 * MiB_, WS_ST = 417 * MiB_, WS_ATT = 420 * MiB_, WS_AGG = 436 * MiB_, WS_HB = 438 * MiB_, WS_TMP = 478 * MiB_, WS_MRG = 542 * MiB_, WS_A2 = 574 * MiB_,
                 WS_SSQ = 606 * MiB_, WS_HID = 607 * MiB_, WS_CTL = 695 * MiB_, WS_END = 696 * MiB_;
constexpr size_t CTL_ZERO_BYTES = 16384;
constexpr size_t SM_STRIDE = 256 * 1024;
enum SmallBuf { SM_QS = 0, SM_XBS, SM_GGS, SM_SAS, SM_SBS, SM_OGS, SM_STS, SM_ATTS, SM_HBS, SM_TMPS, SM_MRGS, SM_X1S, SM_A2S, SM_SSQS, SM_HIDS, SM_XCS, SM_XCF, SM_N };
static_assert((SM_N + 2) * SM_STRIDE <= 6 * MiB_, "sample buffers");
__device__ __forceinline__ float bf2f(unsigned short b) { return __uint_as_float((unsigned)b << 16); }
__device__ __forceinline__ float sigmoidf_(float x) { return __builtin_amdgcn_rcpf(1.0f + __builtin_amdgcn_exp2f(-x * LOG2E_)); }
typedef float f32x4_c __attribute__((ext_vector_type(4)));
__device__ __forceinline__ f32x4_c sigmoid4_(f32x4_c x) { const f32x4_c t = x * (-LOG2E_); f32x4_c e; e[0] = __builtin_amdgcn_exp2f(t[0]); e[1] = __builtin_amdgcn_exp2f(t[1]); e[2] = __builtin_amdgcn_exp2f(t[2]); e[3] = __builtin_amdgcn_exp2f(t[3]);
    const f32x4_c d = e + 1.0f; f32x4_c r; r[0] = __builtin_amdgcn_rcpf(d[0]); r[1] = __builtin_amdgcn_rcpf(d[1]); r[2] = __builtin_amdgcn_rcpf(d[2]); r[3] = __builtin_amdgcn_rcpf(d[3]); return r; }
__device__ __forceinline__ f32x4_c gelu4_(f32x4_c x) { const f32x4_c u = (x * x * 0.044715f + 1.0f) * x * 1.5957691216057308f; return x * sigmoid4_(u); }
__device__ __forceinline__ float gelu_tanh_(float x) { const float u = 1.5957691216057308f * (x + 0.044715f * x * x * x); return x * sigmoidf_(u); }

namespace pg8 {
#define PG8_LAS __attribute__((address_space(3)))
typedef unsigned short bf16_t;
typedef short bf16x8 __attribute__((ext_vector_type(8)));
typedef float f32x4 __attribute__((ext_vector_type(4)));
typedef unsigned u32x4 __attribute__((ext_vector_type(4)));
constexpr int BM = 256, BK = 64, HALF = 128, HTB = HALF * BK * 2  , STAGE_BYTES = 8 * HTB, NXCD = 8, WGM = 8;

__host__ __device__ __forceinline__ int lds_byte(int r, int c) { const int st = (r >> 4) * 2 + (c >> 5), rr = r & 15, cc = c & 31, ob = rr * 64 + cc * 2; return st * 1024 + (ob ^ (((ob >> 9) & 1) << 5)); }
__host__ __device__ __forceinline__ void stage_rc(int b, int& R, int& C) { const int st = b / 1024, sb = b % 1024, swz = sb ^ (((sb >> 9) & 1) << 5); R = (st >> 1) * 16 + swz / 64; C = (st & 1) * 32 + (swz % 64) / 2; }
__host__ __device__ __forceinline__ int perm32(int rho) { const int n = rho >> 4, i = rho & 15; return 8 * (i >> 2) + 4 * n + (i & 3); }

struct Unit { int pm, pn; };
struct Gemm { const bf16_t* A; const bf16_t* Bt; int M, N, K; };

struct StaticOrder {
    int nM, nN, nwg, G, c;
    __host__ __device__ void init(int M, int N, int G_, int c_) { nM = M / BM; nN = N / BM; nwg = nM * nN; G = G_; c = c_; }
    __host__ __device__ bool next(int i, Unit& u) const {
        const long L = (long)i * G + c; if (L >= nwg) return false;
        int wgid = (int)L; { const int q = nwg / NXCD, r = nwg % NXCD, xcd = wgid % NXCD, off = wgid / NXCD; wgid = (xcd < r ? xcd * (q + 1) : r * (q + 1) + (xcd - r) * q) + off; }
        const int nig = WGM * nN, gid = wgid / nig, fm = gid * WGM, gsz = (nM - fm) < WGM ? (nM - fm) : WGM;
        u.pm = fm + ((wgid % nig) % gsz); u.pn = (wgid % nig) / gsz; return true;
    }
    __device__ __forceinline__ void a_ready(const Unit&) const {}
    __device__ __forceinline__ void done(const Unit&) const {}
};

typedef float f32x2_cv __attribute__((ext_vector_type(2))); typedef __bf16 bf16x2_cv __attribute__((ext_vector_type(2)));
__device__ __forceinline__ unsigned cvt_pk_bf16(float lo, float hi) { f32x2_cv v = {lo, hi}; bf16x2_cv b = __builtin_convertvector(v, bf16x2_cv); return __builtin_bit_cast(unsigned, b); }
typedef float f32x2 __attribute__((ext_vector_type(2)));
__device__ __forceinline__ u32x4 pack8(const f32x4 a, const f32x4 b) { u32x4 w; w.x = cvt_pk_bf16(a[0], a[1]); w.y = cvt_pk_bf16(a[2], a[3]); w.z = cvt_pk_bf16(b[0], b[1]); w.w = cvt_pk_bf16(b[2], b[3]); return w; }
__device__ __forceinline__ void unpack8(const u32x4 w, f32x4& a, f32x4& b) {
    a[0] = __uint_as_float(w.x << 16); a[1] = __uint_as_float(w.x & 0xffff0000u); a[2] = __uint_as_float(w.y << 16); a[3] = __uint_as_float(w.y & 0xffff0000u);
    b[0] = __uint_as_float(w.z << 16); b[1] = __uint_as_float(w.z & 0xffff0000u); b[2] = __uint_as_float(w.w << 16); b[3] = __uint_as_float(w.w & 0xffff0000u); }

struct EpiIn {
    static constexpr bool PERM = true, AFTER_DRAIN = false;
    bf16_t *Q, *K, *V, *XB, *GG, *SA, *SB; float* out; const float *qg, *kg, *bgate;
    __device__ __forceinline__ void operator()(const f32x4 (&acc)[2][2][4][2], const Unit& u, int wr, int wc, int fr, int fq) const {
        const int pn = u.pn, row0 = u.pm * BM + wr * 64 + fr;
        const int cin = 64 * wc + 8 * fq;
        if (pn < 12) {
            const bool isq = pn < 6; const float* gv = isq ? qg : kg; const float sc = isq ? QSCALE_ : 1.0f;
            f32x4 gw[2][2];
#pragma unroll
            for (int bj = 0; bj < 2; ++bj)
#pragma unroll
                for (int n = 0; n < 2; ++n) gw[bj][n] = *(const f32x4*)(gv + 32 * bj + 8 * fq + 4 * n) * sc;
            bf16_t* dst = isq ? Q : K; const int cb = (isq ? pn : pn - 6) * 256 + cin;
            const int g = (pn - 6) >> 1, keep = 128 << (2 * (g < 0 ? 0 : g)), start = S_ - keep;
            const size_t obase = g <= 0 ? O_KVP0 : (g == 1 ? O_KVP1 : O_KVP2);
#pragma unroll
            for (int ai = 0; ai < 2; ++ai)
#pragma unroll
                for (int m = 0; m < 4; ++m) {
                    const int row = row0 + ai * HALF + m * 16;
                    float ss = 0.f;
#pragma unroll
                    for (int bj = 0; bj < 2; ++bj)
#pragma unroll
                        for (int n = 0; n < 2; ++n) { const f32x4 x = acc[ai][bj][m][n]; ss += (x[0] * x[0] + x[1] * x[1]) + (x[2] * x[2] + x[3] * x[3]); }
                    ss += __shfl_xor(ss, 16); ss += __shfl_xor(ss, 32);
                    const float rstd = __builtin_amdgcn_rsqf(ss * (1.0f / 64.0f) + RMS_EPS_);
#pragma unroll
                    for (int bj = 0; bj < 2; ++bj) {
                        const f32x4 v0 = acc[ai][bj][m][0] * rstd * gw[bj][0], v1 = acc[ai][bj][m][1] * rstd * gw[bj][1];
                        const int c = cb + 32 * bj;
                        *(u32x4*)(dst + (size_t)row * QKV_ + c) = pack8(v0, v1);
                        if (!isq && row >= start) { float* o = out + obase + (size_t)(row - start) * 1024 + (c & 511); *(f32x4*)o = v0; *(f32x4*)(o + 4) = v1; }
                    }
                }
        } else if (pn < 18) {
            const int cb = (pn - 12) * 256 + cin; const int g = (pn - 12) >> 1, keep = 128 << (2 * g), start = S_ - keep;
            const size_t obase = g == 0 ? O_KVP0 : (g == 1 ? O_KVP1 : O_KVP2);
#pragma unroll
            for (int ai = 0; ai < 2; ++ai)
#pragma unroll
                for (int m = 0; m < 4; ++m) {
                    const int row = row0 + ai * HALF + m * 16;
#pragma unroll
                    for (int bj = 0; bj < 2; ++bj) {
                        const f32x4 v0 = acc[ai][bj][m][0], v1 = acc[ai][bj][m][1]; const int c = cb + 32 * bj;
                        *(u32x4*)(V + (size_t)row * QKV_ + c) = pack8(v0, v1);
                        if (row >= start) { float* o = out + obase + (size_t)(row - start) * 1024 + 512 + (c & 511); *(f32x4*)o = v0; *(f32x4*)(o + 4) = v1; }
                    }
                }
        } else if (pn < 28) {
            const bool isx = pn < 23; bf16_t* dst = isx ? XB : GG; const int cb = (isx ? pn - 18 : pn - 23) * 256 + cin;
#pragma unroll
            for (int ai = 0; ai < 2; ++ai)
#pragma unroll
                for (int m = 0; m < 4; ++m) {
                    const int row = row0 + ai * HALF + m * 16;
#pragma unroll
                    for (int bj = 0; bj < 2; ++bj) {
                        f32x4 v0 = acc[ai][bj][m][0], v1 = acc[ai][bj][m][1]; const int c = cb + 32 * bj;
                        if (!isx) { v0 = gelu4_(v0); v1 = gelu4_(v1); }
                        *(u32x4*)(dst + (size_t)row * DR_ + c) = pack8(v0, v1);
                        if (isx && row >= S_ - 3) { float* o = out + O_CONVP + (size_t)(row - (S_ - 3)) * DR_ + c; *(f32x4*)o = v0; *(f32x4*)(o + 4) = v1; }
                    }
                }
        } else {
            const bool isa = pn < 32; bf16_t* dst = isa ? SA : SB; const int cb = (isa ? pn - 28 : pn - 32) * 256 + cin; const float* bg = bgate + (isa ? 0 : DM_);
            f32x4 bv[2][2];
#pragma unroll
            for (int bj = 0; bj < 2; ++bj)
#pragma unroll
                for (int n = 0; n < 2; ++n) bv[bj][n] = *(const f32x4*)(bg + cb + 32 * bj + 4 * n);
#pragma unroll
            for (int ai = 0; ai < 2; ++ai)
#pragma unroll
                for (int m = 0; m < 4; ++m) {
                    const int row = row0 + ai * HALF + m * 16;
#pragma unroll
                    for (int bj = 0; bj < 2; ++bj) {
                        f32x4 v0 = acc[ai][bj][m][0] + bv[bj][0], v1 = acc[ai][bj][m][1] + bv[bj][1]; const int c = cb + 32 * bj;
                        *(u32x4*)(dst + (size_t)row * DM_ + c) = pack8(v0, v1);
                    }
                }
        }
    }
};
struct EpiYa {
    static constexpr bool PERM = true, AFTER_DRAIN = false;
    const bf16_t* SA; bf16_t* TMP;
    __device__ __forceinline__ void operator()(const f32x4 (&acc)[2][2][4][2], const Unit& u, int wr, int wc, int fr, int fq) const {
        const int row0 = u.pm * BM + wr * 64 + fr, col0 = u.pn * BM + wc * 32 + 8 * fq;
#pragma unroll
        for (int ai = 0; ai < 2; ++ai)
#pragma unroll
            for (int m = 0; m < 4; ++m)
#pragma unroll
                for (int bj = 0; bj < 2; ++bj) {
                    const size_t off = (size_t)(row0 + ai * HALF + m * 16) * DM_ + col0 + bj * HALF;
                    f32x4 s0, s1; unpack8(*(const u32x4*)(SA + off), s0, s1); s0 = sigmoid4_(s0); s1 = sigmoid4_(s1);
                    *(u32x4*)(TMP + off) = pack8(acc[ai][bj][m][0] * s0, acc[ai][bj][m][1] * s1);
                }
    }
};
struct EpiYb {
    static constexpr bool PERM = true, AFTER_DRAIN = false;
    const bf16_t* SB; const bf16_t* TMP; bf16_t* MRG;
    __device__ __forceinline__ void operator()(const f32x4 (&acc)[2][2][4][2], const Unit& u, int wr, int wc, int fr, int fq) const {
        const int row0 = u.pm * BM + wr * 64 + fr, col0 = u.pn * BM + wc * 32 + 8 * fq;
#pragma unroll
        for (int ai = 0; ai < 2; ++ai)
#pragma unroll
            for (int m = 0; m < 4; ++m)
#pragma unroll
                for (int bj = 0; bj < 2; ++bj) {
                    const size_t off = (size_t)(row0 + ai * HALF + m * 16) * DM_ + col0 + bj * HALF;
                    f32x4 s0, s1; unpack8(*(const u32x4*)(SB + off), s0, s1); s0 = sigmoid4_(s0); s1 = sigmoid4_(s1);
                    f32x4 t0, t1; unpack8(*(const u32x4*)(TMP + off), t0, t1);
                    *(u32x4*)(MRG + off) = pack8(t0 + acc[ai][bj][m][0] * s0, t1 + acc[ai][bj][m][1] * s1);
                }
    }
};
struct EpiWout {
    static constexpr bool PERM = true, AFTER_DRAIN = false;
    const float* X; float* Y; bf16_t* A2; float* SSQ; const float* g2;
    __device__ __forceinline__ void operator()(const f32x4 (&acc)[2][2][4][2], const Unit& u, int wr, int wc, int fr, int fq) const {
        const int row0 = u.pm * BM + wr * 64 + fr, col0 = u.pn * BM + wc * 32 + 8 * fq;
        f32x4 gw[2][2];
#pragma unroll
        for (int bj = 0; bj < 2; ++bj)
#pragma unroll
            for (int n = 0; n < 2; ++n) gw[bj][n] = *(const f32x4*)(g2 + col0 + bj * HALF + 4 * n);
#pragma unroll
        for (int ai = 0; ai < 2; ++ai)
#pragma unroll
            for (int m = 0; m < 4; ++m) {
                const int row = row0 + ai * HALF + m * 16; float ss = 0.f;
#pragma unroll
                for (int bj = 0; bj < 2; ++bj) {
                    const size_t off = (size_t)row * DM_ + col0 + bj * HALF;
                    const f32x4 x0 = *(const f32x4*)(X + off) + acc[ai][bj][m][0], x1 = *(const f32x4*)(X + off + 4) + acc[ai][bj][m][1];
                    *(f32x4*)(Y + off) = x0; *(f32x4*)(Y + off + 4) = x1;
                    ss += (x0[0] * x0[0] + x0[1] * x0[1]) + (x0[2] * x0[2] + x0[3] * x0[3]) + (x1[0] * x1[0] + x1[1] * x1[1]) + (x1[2] * x1[2] + x1[3] * x1[3]);
                    *(u32x4*)(A2 + off) = pack8(x0 * gw[bj][0], x1 * gw[bj][1]);
                }
                ss += __shfl_xor(ss, 16); ss += __shfl_xor(ss, 32);
                if (fq == 0) SSQ[(size_t)row * 16 + u.pn * 4 + wc] = ss;
            }
    }
};
struct EpiFfn1 {
    static constexpr bool PERM = true, AFTER_DRAIN = false;
    const float* SSQ; bf16_t* HID;
    __device__ __forceinline__ void operator()(const f32x4 (&acc)[2][2][4][2], const Unit& u, int wr, int wc, int fr, int fq) const {
        const int row0 = u.pm * BM + wr * 64 + fr, col0 = u.pn * HALF + wc * 32 + 8 * fq;
#pragma unroll
        for (int ai = 0; ai < 2; ++ai)
#pragma unroll
            for (int m = 0; m < 4; ++m) {
                const int row = row0 + ai * HALF + m * 16;
                const f32x4* sp = (const f32x4*)(SSQ + (size_t)row * 16);
                const f32x4 p0 = sp[0], p1 = sp[1], p2 = sp[2], p3 = sp[3];
                const float ssum = ((p0[0] + p0[1]) + (p0[2] + p0[3])) + ((p1[0] + p1[1]) + (p1[2] + p1[3])) + ((p2[0] + p2[1]) + (p2[2] + p2[3])) + ((p3[0] + p3[1]) + (p3[2] + p3[3]));
                const float rstd = __builtin_amdgcn_rsqf(ssum * (1.0f / 1024.0f) + RMS_EPS_);
                const f32x4 g0 = acc[ai][0][m][0] * rstd, u0 = acc[ai][1][m][0] * rstd, g1 = acc[ai][0][m][1] * rstd, u1 = acc[ai][1][m][1] * rstd;
                const f32x4 h0 = g0 * sigmoid4_(g0) * u0, h1 = g1 * sigmoid4_(g1) * u1;
                *(u32x4*)(HID + (size_t)row * DFF_ + col0) = pack8(h0, h1);
            }
    }
};
struct EpiOut {
    static constexpr bool PERM = true, AFTER_DRAIN = false;
    float* Y;
    __device__ __forceinline__ void operator()(const f32x4 (&acc)[2][2][4][2], const Unit& u, int wr, int wc, int fr, int fq) const {
        const int row0 = u.pm * BM + wr * 64 + fr, col0 = u.pn * BM + wc * 32 + 8 * fq;
#pragma unroll
        for (int ai = 0; ai < 2; ++ai)
#pragma unroll
            for (int m = 0; m < 4; ++m)
#pragma unroll
                for (int bj = 0; bj < 2; ++bj) {
                    float* p = Y + (size_t)(row0 + ai * HALF + m * 16) * DM_ + col0 + bj * HALF;
                    const f32x4 a = *(const f32x4*)p + acc[ai][bj][m][0], b = *(const f32x4*)(p + 4) + acc[ai][bj][m][1];
                    *(f32x4*)p = a; *(f32x4*)(p + 4) = b;
                }
    }
};

template <class Epi, class Sched, bool ALIGN_EPI = false, bool SP2 = false>
__device__ __forceinline__ void gemm_phase(PG8_LAS unsigned char* lds, const Gemm g, const Sched& S, const Epi& E) {
    const int tid = threadIdx.x, wid = __builtin_amdgcn_readfirstlane(tid >> 6), lane = tid & 63, wr = wid >> 2, wc = wid & 3, fr = lane & 15, fq = lane >> 4;
    const int K = g.K, nt = K / BK;
    unsigned voffA[2], voffB[2];
#pragma unroll
    for (int i = 0; i < 2; ++i) { int R, C; stage_rc(tid * 16 + i * 8192, R, C); const int Rb = Epi::PERM ? ((R & ~31) + perm32(R & 31)) : R;
        voffA[i] = (unsigned)(R * K + C) * 2u; voffB[i] = (unsigned)(Rb * K + C) * 2u; }
    const size_t kstep = (size_t)(BK * 2);
    const size_t hstep = (size_t)HALF * K * 2;
    const size_t tstep = 2 * hstep;
    const unsigned ldsw = (unsigned)wid * 1024u;
    const int aoff = lds_byte(wr * 64 + fr, fq * 8), boff = lds_byte(wc * 32 + fr, fq * 8);
#define PG8_SA(b, h) (((b) * 2 + (h)) * HTB)
#define PG8_SB(b, h) ((4 + (b) * 2 + (h)) * HTB)
#define PG8_STAGE(bufoff, gbase, voff) do { _Pragma("unroll") for (int _i = 0; _i < 2; ++_i) \
        __builtin_amdgcn_global_load_lds((const unsigned*)((const char*)(gbase) + (voff)[_i]), (PG8_LAS unsigned*)(lds + (bufoff) + ldsw + _i * 8192), 16, 0, 0); } while (0)
#define PG8_LDA(dst, b, h) do { _Pragma("unroll") for (int m = 0; m < 4; ++m) _Pragma("unroll") for (int k = 0; k < 2; ++k) dst[m][k] = *(const PG8_LAS bf16x8*)(lds + PG8_SA(b, h) + aoff + m * 2048 + k * 1024); } while (0)
#define PG8_LDB(dst, b, h) do { _Pragma("unroll") for (int n = 0; n < 2; ++n) _Pragma("unroll") for (int k = 0; k < 2; ++k) dst[n][k] = *(const PG8_LAS bf16x8*)(lds + PG8_SB(b, h) + boff + n * 2048 + k * 1024); } while (0)
#define PG8_MMA(ai, bj, At, Bt) do { __builtin_amdgcn_s_setprio(1); _Pragma("unroll") for (int m = 0; m < 4; ++m) _Pragma("unroll") for (int n = 0; n < 2; ++n) _Pragma("unroll") for (int k = 0; k < 2; ++k) \
        acc[ai][bj][m][n] = __builtin_amdgcn_mfma_f32_16x16x32_bf16(Bt[n][k], At[m][k], acc[ai][bj][m][n], 0, 0, 0); __builtin_amdgcn_s_setprio(0); } while (0)
#define PG8_WAIT_V(n) asm volatile("s_waitcnt vmcnt(" #n ")" ::: "memory")
#define PG8_WAIT_L(n) asm volatile("s_waitcnt lgkmcnt(" #n ")" ::: "memory")
#define PG8_BAR __builtin_amdgcn_s_barrier()
#define PG8_SCHED __builtin_amdgcn_sched_barrier(0)
    Unit cur, nxt; int ui = 0;
    if (!S.next(0, cur)) return;
    f32x4 acc[2][2][4][2];
#pragma unroll
    for (int a = 0; a < 2; ++a)
#pragma unroll
        for (int b = 0; b < 2; ++b)
#pragma unroll
            for (int m = 0; m < 4; ++m)
#pragma unroll
                for (int n = 0; n < 2; ++n) acc[a][b][m][n] = (f32x4){0.f, 0.f, 0.f, 0.f};
    bf16x8 At[4][2], B0[2][2], B1[2][2];
    const char* cA = (const char*)g.A + (size_t)cur.pm * tstep; const char* cB = (const char*)g.Bt + (size_t)cur.pn * tstep;
    S.a_ready(cur);
    if constexpr (SP2) {
        PG8_STAGE(PG8_SB(0, 0), cB, voffB); PG8_STAGE(PG8_SB(0, 1), cB + hstep, voffB); PG8_STAGE(PG8_SA(0, 0), cA, voffA); PG8_STAGE(PG8_SA(0, 1), cA + hstep, voffA);
        if (wr == 1) PG8_BAR;
        PG8_WAIT_V(2); PG8_BAR;
        PG8_STAGE(PG8_SB(1, 0), cB + kstep, voffB); PG8_STAGE(PG8_SA(1, 0), cA + kstep, voffA); PG8_STAGE(PG8_SB(1, 1), cB + hstep + kstep, voffB);
        PG8_WAIT_V(6); PG8_BAR;
    } else {
        PG8_STAGE(PG8_SB(0, 0), cB, voffB); PG8_STAGE(PG8_SA(0, 0), cA, voffA); PG8_STAGE(PG8_SB(0, 1), cB + hstep, voffB); PG8_STAGE(PG8_SA(0, 1), cA + hstep, voffA);
        if (wr == 1) PG8_BAR;
        PG8_WAIT_V(4); PG8_BAR;
        PG8_STAGE(PG8_SB(1, 0), cB + kstep, voffB); PG8_STAGE(PG8_SA(1, 0), cA + kstep, voffA); PG8_STAGE(PG8_SB(1, 1), cB + hstep + kstep, voffB);
        PG8_WAIT_V(6); PG8_BAR;
    }
    for (;;) {
        const bool has_next = S.next(ui + 1, nxt);
        const char* nA = has_next ? (const char*)g.A + (size_t)nxt.pm * tstep : cA; const char* nB = has_next ? (const char*)g.Bt + (size_t)nxt.pn * tstep : cB;
        for (int t = 0; t < nt; t += 2) {
            const bool last = (t == nt - 2);
            const char* a1 = cA + (size_t)(t + 1) * kstep;
            const char* a2 = last ? nA : cA + (size_t)(t + 2) * kstep; const char* b2 = last ? nB : cB + (size_t)(t + 2) * kstep;
            const char* a3 = a2 + kstep; const char* b3 = b2 + kstep;
            if (last && has_next) S.a_ready(nxt);
            if constexpr (SP2) {
            PG8_LDB(B0, 0, 0); PG8_LDB(B1, 0, 1); PG8_SCHED; PG8_LDA(At, 0, 0); PG8_STAGE(PG8_SA(1, 1), a1 + hstep, voffA);
            PG8_WAIT_V(8); PG8_WAIT_L(0); PG8_BAR; PG8_MMA(0, 0, At, B0); PG8_MMA(0, 1, At, B1); PG8_BAR; PG8_SCHED;
            PG8_LDA(At, 0, 1); PG8_STAGE(PG8_SB(0, 0), b2, voffB); PG8_STAGE(PG8_SB(0, 1), b2 + hstep, voffB); PG8_STAGE(PG8_SA(0, 0), a2, voffA);
            PG8_WAIT_V(8); PG8_WAIT_L(0); PG8_BAR; PG8_MMA(1, 0, At, B0); PG8_MMA(1, 1, At, B1); PG8_BAR; PG8_SCHED;
            PG8_LDB(B0, 1, 0); PG8_LDB(B1, 1, 1); PG8_SCHED; PG8_LDA(At, 1, 0); PG8_STAGE(PG8_SA(0, 1), a2 + hstep, voffA);
            PG8_WAIT_V(8); PG8_WAIT_L(0); PG8_BAR; PG8_MMA(0, 0, At, B0); PG8_MMA(0, 1, At, B1); PG8_BAR; PG8_SCHED;
            PG8_LDA(At, 1, 1); PG8_STAGE(PG8_SB(1, 0), b3, voffB); PG8_STAGE(PG8_SB(1, 1), b3 + hstep, voffB); PG8_STAGE(PG8_SA(1, 0), a3, voffA);
            PG8_WAIT_V(8); PG8_WAIT_L(0); PG8_BAR; PG8_MMA(1, 0, At, B0); PG8_MMA(1, 1, At, B1); PG8_BAR; PG8_SCHED;
            } else {
            PG8_LDB(B0, 0, 0); PG8_SCHED; PG8_LDA(At, 0, 0); PG8_STAGE(PG8_SA(1, 1), a1 + hstep, voffA);
            PG8_WAIT_L(8); PG8_BAR; PG8_WAIT_L(0); PG8_MMA(0, 0, At, B0); PG8_BAR; PG8_SCHED;
            PG8_LDB(B1, 0, 1); PG8_STAGE(PG8_SB(0, 0), b2, voffB);
            PG8_BAR; PG8_WAIT_L(0); PG8_MMA(0, 1, At, B1); PG8_BAR;
            PG8_LDA(At, 0, 1); PG8_STAGE(PG8_SA(0, 0), a2, voffA);
            PG8_BAR; PG8_WAIT_L(0); PG8_MMA(1, 0, At, B0); PG8_BAR; PG8_SCHED;
            PG8_STAGE(PG8_SB(0, 1), b2 + hstep, voffB);
            PG8_WAIT_V(6); PG8_BAR; PG8_MMA(1, 1, At, B1); PG8_BAR;
            PG8_LDB(B0, 1, 0); PG8_SCHED; PG8_LDA(At, 1, 0); PG8_STAGE(PG8_SA(0, 1), a2 + hstep, voffA);
            PG8_WAIT_L(8); PG8_BAR; PG8_WAIT_L(0); PG8_MMA(0, 0, At, B0); PG8_BAR; PG8_SCHED;
            PG8_LDB(B1, 1, 1); PG8_STAGE(PG8_SB(1, 0), b3, voffB);
            PG8_BAR; PG8_WAIT_L(0); PG8_MMA(0, 1, At, B1); PG8_BAR;
            PG8_LDA(At, 1, 1); PG8_STAGE(PG8_SA(1, 0), a3, voffA);
            PG8_BAR; PG8_WAIT_L(0); PG8_MMA(1, 0, At, B0); PG8_BAR; PG8_SCHED;
            PG8_STAGE(PG8_SB(1, 1), b3 + hstep, voffB);
            PG8_WAIT_V(6); PG8_BAR; PG8_MMA(1, 1, At, B1); PG8_BAR;
            }
        }
        if constexpr (ALIGN_EPI) { if (wr == 0) PG8_BAR; }
        if constexpr (!Epi::AFTER_DRAIN) { E(acc, cur, wr, wc, fr, fq); S.done(cur); }
        if (!has_next) break;
#pragma unroll
        for (int a = 0; a < 2; ++a)
#pragma unroll
            for (int b = 0; b < 2; ++b)
#pragma unroll
                for (int m = 0; m < 4; ++m)
#pragma unroll
                    for (int n = 0; n < 2; ++n) acc[a][b][m][n] = (f32x4){0.f, 0.f, 0.f, 0.f};
        cur = nxt; cA = nA; cB = nB; ++ui;
        if constexpr (ALIGN_EPI) { if (wr == 1) PG8_BAR; }
    }
    PG8_WAIT_V(0);
    if constexpr (!ALIGN_EPI) { if (wr == 0) PG8_BAR; }
    PG8_BAR;
    if constexpr (Epi::AFTER_DRAIN) { E.fused(acc, cur, wr, wc, fr, fq, lds, wid, lane); S.done(cur); }
#undef PG8_SA
#undef PG8_SB
#undef PG8_STAGE
#undef PG8_LDA
#undef PG8_LDB
#undef PG8_MMA
#undef PG8_WAIT_V
#undef PG8_WAIT_L
#undef PG8_BAR
#undef PG8_SCHED
}
}

#define LAS __attribute__((address_space(3)))
typedef unsigned short bf16_t;
typedef short bf16x8 __attribute__((ext_vector_type(8)));
typedef float f32x4 __attribute__((ext_vector_type(4)));
typedef float f32x2 __attribute__((ext_vector_type(2)));
typedef float f32x16 __attribute__((ext_vector_type(16)));
typedef unsigned u32x4 __attribute__((ext_vector_type(4)));
typedef unsigned u32x2 __attribute__((ext_vector_type(2)));
constexpr int NWAVES = 8, NTHREADS = 512;
constexpr int RING_BYTES = 131072, MISC_OFF = RING_BYTES, LDS_BYTES = 147456;
using pg8::cvt_pk_bf16; using pg8::pack8; using pg8::unpack8;

struct Args {
    const float *x, *xs, *c128, *c512, *c2048, *sconv, *sh, *n1g, *w_in, *bgate, *qg, *kg, *convw, *convb, *w_rg, *b_rg, *w_ig, *b_ig, *lam, *w_oa, *w_ob, *w_out, *n2g, *w_f1, *w_f2;
    float* out; unsigned char* ws; int ph_lo, ph_hi;
};

__device__ __forceinline__ float wave_sum(float v) {
#pragma unroll
    for (int o = 1; o < 64; o <<= 1) v += __shfl_xor(v, o);
    return v;
}

#define RLX_AGENT __ATOMIC_RELAXED, __HIP_MEMORY_SCOPE_AGENT
#define XB_TMO      128
#define XB_XCNT(j)  (256  + 64 * (j))
#define XB_XSUB(j)  (1280 + 64 * (j))
#define XB_XGEN(j)  (2304 + 64 * (j))
#define XB_TOP      3328
#define XB_TOPGEN   3392
#define XCD_BAR_WORDS 3456
#define XB_SPIN_CAP (1u << 18)

__device__ __forceinline__ unsigned xb_ld(unsigned* p)              { return __hip_atomic_load(p, __ATOMIC_RELAXED, __HIP_MEMORY_SCOPE_AGENT); }
__device__ __forceinline__ unsigned xb_add(unsigned* p, unsigned v) { return __hip_atomic_fetch_add(p, v, __ATOMIC_RELAXED, __HIP_MEMORY_SCOPE_AGENT); }
__device__ __forceinline__ unsigned xb_xcc_id() { return (unsigned)__builtin_amdgcn_s_getreg((3 << 11) | 20) & 0xFu; }
#define XB_SPIN(cond, bar) do { unsigned _sp = 0; while (cond) { __builtin_amdgcn_s_sleep(1); \
    if ((++_sp & 255u) == 0u) { if (xb_ld(&(bar)[XB_TMO])) break; if (_sp > XB_SPIN_CAP) { atomicAdd(&(bar)[XB_TMO], 1u); break; } } } } while (0)

struct XcdBarrier {
    unsigned* bar; unsigned x;
    volatile LAS unsigned* st;
};

__device__ __forceinline__ XcdBarrier xcd_barrier_post(unsigned* bar, volatile LAS unsigned* st) {
    XcdBarrier b; b.bar = bar; b.x = xb_xcc_id(); b.st = st;
    if (threadIdx.x == 0) (void)xb_add(&bar[XB_XCNT(b.x)], 1u);
    return b;
}
__device__ __forceinline__ void xcd_barrier_complete(unsigned* bar, unsigned x, unsigned& nloc, unsigned& nx) {
    const unsigned G = gridDim.x * gridDim.y * gridDim.z;
    unsigned sum, cnt, mine, sp = 0u;
    for (;;) {
        sum = 0u; cnt = 0u; mine = 0u;
#pragma unroll
        for (unsigned j = 0; j < 16; ++j) { const unsigned c = xb_ld(&bar[XB_XCNT(j)]); sum += c; cnt += (c > 0u) ? 1u : 0u; mine = (j == x) ? c : mine; }
        if (sum == G) break;
        __builtin_amdgcn_s_sleep(1);
        if ((++sp & 255u) == 0u) { if (xb_ld(&bar[XB_TMO])) break; if (sp > XB_SPIN_CAP) { atomicAdd(&bar[XB_TMO], 1u); break; } }
    }
    nloc = mine > 0u ? mine : 1u; nx = cnt > 0u ? cnt : 1u;
}

__device__ __forceinline__ void xcd_barrier(const XcdBarrier& b) {
    asm volatile("s_waitcnt vmcnt(0)" ::: "memory");
    __syncthreads();
    if (threadIdx.x == 0) {
        unsigned* bar = b.bar;
        __builtin_amdgcn_s_waitcnt(0);
        unsigned nloc = b.st[0], nx = b.st[1];
        if (nloc == 0u) { xcd_barrier_complete(bar, b.x, nloc, nx); b.st[0] = nloc; b.st[1] = nx; }
        const unsigned old = xb_add(&bar[XB_XSUB(b.x)], 1u);
        const unsigned gen = old / nloc;
        if (old + 1u == (gen + 1u) * nloc) {
            __builtin_amdgcn_fence(__ATOMIC_RELEASE, "agent");
            asm volatile("s_waitcnt vmcnt(0)" ::: "memory");
            const unsigned og = xb_add(&bar[XB_TOP], 1u);
            const unsigned tg = og / nx;
            if (og + 1u == (tg + 1u) * nx) xb_add(&bar[XB_TOPGEN], 1u);
            else XB_SPIN(xb_ld(&bar[XB_TOPGEN]) == tg, bar);
            __builtin_amdgcn_fence(__ATOMIC_ACQUIRE, "agent");
            xb_add(&bar[XB_XGEN(b.x)], 1u);
            asm volatile("s_waitcnt vmcnt(0)" ::: "memory");
        } else {
            XB_SPIN(xb_ld(&bar[XB_XGEN(b.x)]) == gen, bar);
            __builtin_amdgcn_fence(__ATOMIC_ACQUIRE, "agent");
            asm volatile("s_waitcnt vmcnt(0)" ::: "memory");
        }
    }
    __syncthreads();
}

__device__ __forceinline__ void tr_item(const float* W, int ldw, int k0, int n0, bf16_t* WT, int ldt, int dst_row0, LAS float* scr, int lane) {
    float wv[32];
#pragma unroll
    for (int i = 0; i < 32; ++i) wv[i] = W[(size_t)(k0 + 2 * i + (lane >> 5)) * ldw + n0 + (lane & 31)];
#pragma unroll
    for (int i = 0; i < 32; ++i) scr[(2 * i + (lane >> 5)) * 33 + (lane & 31)] = wv[i];
    asm volatile("s_waitcnt lgkmcnt(0)" ::: "memory");
    const int c = lane & 7;
#pragma unroll
    for (int j = 0; j < 4; ++j) { const int n = (lane >> 3) + 8 * j; const LAS float* s = scr + (8 * c) * 33 + n;
        u32x4 o; o.x = cvt_pk_bf16(s[0 * 33], s[1 * 33]); o.y = cvt_pk_bf16(s[2 * 33], s[3 * 33]); o.z = cvt_pk_bf16(s[4 * 33], s[5 * 33]); o.w = cvt_pk_bf16(s[6 * 33], s[7 * 33]);
        *(u32x4*)(WT + (size_t)(dst_row0 + n) * ldt + k0 + 8 * c) = o; }
    asm volatile("s_waitcnt lgkmcnt(0)" ::: "memory");
}
template <int PART>
__device__ __forceinline__ void p0_prologue(const Args& a, LAS unsigned char* lds, int blk, int G) {
    const int tid = threadIdx.x, lane = tid & 63, wid = tid >> 6;
    LAS float* scr = (LAS float*)(lds + wid * 16384);
    const int gw = blk * NWAVES + wid, NGW = G * NWAVES;
    unsigned char* ws = a.ws;
    constexpr int I_IN = 16 * 288, I_G = 160, I_OA = 8 * 32, I_OB = 20 * 32, I_OUT = 16 * 32, I_F1 = 16 * 176, I_F2 = 44 * 32;
    constexpr int NITEMS = I_IN + I_G + I_OA + I_OB + I_OUT + I_F1 + I_F2;
    for (int it = (PART == 0 ? gw : I_IN + I_G + gw); it < (PART == 0 ? I_IN + I_G : NITEMS); it += NGW) {
        int r = it;
        if (r < I_IN) { const int kb = r / 288, nb = r % 288, c = 32 * nb; const int dst = (c & ~255) + 128 * ((c >> 5) & 1) + 32 * ((c >> 6) & 3);
            tr_item(a.w_in, INW_, 64 * kb, c, (bf16_t*)(ws + WS_WIN), DM_, dst, scr, lane); continue; } r -= I_IN;
        if (r < I_G) { const int mat = r >> 3, l = r & 7, n = mat >> 1, which = mat & 1, kb = l >> 2, nb = l & 3;
            tr_item((which ? a.w_ig : a.w_rg) + (size_t)n * 16384, 128, 64 * kb, 32 * nb, (bf16_t*)(ws + WS_WG), 128, n * 256 + which * 128 + 32 * nb, scr, lane); continue; } r -= I_G;
        if (r < I_OA) { const int kb = r / 32, nb = r % 32; tr_item(a.w_oa, DM_, 64 * kb, 32 * nb, (bf16_t*)(ws + WS_WOA), 512, 32 * nb, scr, lane); continue; } r -= I_OA;
        if (r < I_OB) { const int kb = r / 32, nb = r % 32; tr_item(a.w_ob, DM_, 64 * kb, 32 * nb, (bf16_t*)(ws + WS_WOB), DR_, 32 * nb, scr, lane); continue; } r -= I_OB;
        if (r < I_OUT) { const int kb = r / 32, nb = r % 32; tr_item(a.w_out, DM_, 64 * kb, 32 * nb, (bf16_t*)(ws + WS_WOUT), DM_, 32 * nb, scr, lane); continue; } r -= I_OUT;
        if (r < I_F1) { const int kb = r / 176, nb = r % 176, c = 32 * nb, bj = c >= DFF_ ? 1 : 0, cc = c - bj * DFF_; const int dst = 256 * (cc >> 7) + 128 * bj + (cc & 127);
            tr_item(a.w_f1, 2 * DFF_, 64 * kb, c, (bf16_t*)(ws + WS_WFF1), DM_, dst, scr, lane); continue; } r -= I_F1;
        { const int kb = r / 32, nb = r % 32; tr_item(a.w_f2, DM_, 64 * kb, 32 * nb, (bf16_t*)(ws + WS_WFF2), DFF_, 32 * nb, scr, lane); }
    }
    if (PART != 0) return;
    bf16_t* HN = (bf16_t*)(ws + WS_HN);
    f32x4 gv[4];
#pragma unroll
    for (int j = 0; j < 4; ++j) gv[j] = ((const f32x4*)a.n1g)[64 * j + lane];
    for (int m0 = gw; m0 < S_ + NBS; m0 += 4 * NGW) {
        f32x4 v[4][4];
#pragma unroll
        for (int r = 0; r < 4; ++r) { const int m = m0 + r * NGW; const int mm = m < S_ + NBS ? m : m0;
            const float* xr = mm < S_ ? a.x + (size_t)mm * DM_ : a.xs + (size_t)(mm - S_) * DM_;
#pragma unroll
            for (int j = 0; j < 4; ++j) v[r][j] = ((const f32x4*)xr)[64 * j + lane]; }
#pragma unroll
        for (int r = 0; r < 4; ++r) { const int m = m0 + r * NGW; float s = 0.f;
#pragma unroll
            for (int j = 0; j < 4; ++j) s += (v[r][j][0] * v[r][j][0] + v[r][j][1] * v[r][j][1]) + (v[r][j][2] * v[r][j][2] + v[r][j][3] * v[r][j][3]);
            const float rstd = 1.0f / sqrtf(wave_sum(s) * (1.0f / DM_) + RMS_EPS_);
            if (m < S_ + NBS) { u32x2* o = (u32x2*)(HN + (size_t)m * DM_);
#pragma unroll
                for (int j = 0; j < 4; ++j) { const f32x4 y = v[r][j] * rstd * gv[j]; u32x2 w; w.x = cvt_pk_bf16(y[0], y[1]); w.y = cvt_pk_bf16(y[2], y[3]); o[64 * j + lane] = w; } } }
    }
}

template <int K, int UNR, class Epi>
__device__ __forceinline__ void small_gemm(LAS unsigned char* lds, const bf16_t* A, int lda, const bf16_t* Bt, int ntiles, int G, int blk, const Epi& E) {
    const int tid = threadIdx.x, lane = tid & 63, wid = tid >> 6, r32 = lane & 31, h2 = lane >> 5;
    constexpr int kw = K >> 3, NST = kw / 16; static_assert(NST % UNR == 0, "small_gemm: UNR divides the k-steps per wave");
    LAS float* part = (LAS float*)lds; LAS float* red = (LAS float*)(lds + 65536);
    for (int t = G - 1 - blk; t < ntiles; t += G) {
        int b0, b1, acol; E.rows(t, b0, b1, acol);
        f32x16 c0, c1;
#pragma unroll
        for (int i = 0; i < 16; ++i) { c0[i] = 0.f; c1[i] = 0.f; }
        const bf16_t* ap = A + (size_t)r32 * lda + acol + wid * kw + 8 * h2;
        const bf16_t* bp0 = Bt + (size_t)(b0 + r32) * K + wid * kw + 8 * h2;
        const bf16_t* bp1 = Bt + (size_t)(b1 + r32) * K + wid * kw + 8 * h2;
#pragma unroll 1
        for (int kb = 0; kb < NST; kb += UNR) {
            bf16x8 av[UNR], x0[UNR], x1[UNR];
#pragma unroll
            for (int j = 0; j < UNR; ++j) { av[j] = *(const bf16x8*)(ap + 16 * (kb + j)); x0[j] = *(const bf16x8*)(bp0 + 16 * (kb + j)); x1[j] = *(const bf16x8*)(bp1 + 16 * (kb + j)); }
#pragma unroll
            for (int j = 0; j < UNR; ++j) { c0 = __builtin_amdgcn_mfma_f32_32x32x16_bf16(av[j], x0[j], c0, 0, 0, 0); c1 = __builtin_amdgcn_mfma_f32_32x32x16_bf16(av[j], x1[j], c1, 0, 0, 0); }
        }
#pragma unroll
        for (int r = 0; r < 16; ++r) { const int row = (r & 3) + 8 * (r >> 2) + 4 * h2; part[wid * 2048 + row * 64 + r32] = c0[r]; part[wid * 2048 + row * 64 + 32 + r32] = c1[r]; }
        __syncthreads();
        f32x4 s = *(const LAS f32x4*)(part + tid * 4);
#pragma unroll
        for (int w = 1; w < 8; ++w) s += *(const LAS f32x4*)(part + w * 2048 + tid * 4);
        *(LAS f32x4*)(red + tid * 4) = s;
        __syncthreads();
        E(t, red, tid);
        __syncthreads();
    }
}
struct SEpiIn {
    const Args* a; float *QS, *XBS, *GGS, *SAS, *SBS; bf16_t* XCS; float* XCF;
    __device__ __forceinline__ void rows(int t, int& b0, int& b1, int& acol) const { acol = 0; b0 = 256 * (t >> 2) + 32 * (t & 3); b1 = b0 + 128; }
    __device__ __forceinline__ void operator()(int t, const LAS float* red, int tid) const {
        const int row = tid >> 4, c4 = (tid & 15) * 4; f32x4 v = *(const LAS f32x4*)(red + row * 64 + c4); float* out = a->out;
        if (t < 48) {
            float ss = (v[0] * v[0] + v[1] * v[1]) + (v[2] * v[2] + v[3] * v[3]);
            ss += __shfl_xor(ss, 1); ss += __shfl_xor(ss, 2); ss += __shfl_xor(ss, 4); ss += __shfl_xor(ss, 8);
            const float rstd = 1.0f / sqrtf(ss * (1.0f / 64.0f) + RMS_EPS_);
            if (t < 24) { const f32x4 g = *(const f32x4*)(a->qg + c4); *(f32x4*)(QS + row * QKV_ + 64 * t + c4) = v * rstd * g * QSCALE_; }
            else { const int hh = t - 24, g = hh >> 3, h = hh & 7; const f32x4 gk = *(const f32x4*)(a->kg + c4);
                const size_t ob = g == 0 ? O_KVS0 : (g == 1 ? O_KVS1 : O_KVS2); *(f32x4*)(out + ob + (size_t)row * 1024 + h * 64 + c4) = v * rstd * gk; }
        } else if (t < 72) { const int hh = t - 48, g = hh >> 3, h = hh & 7; const size_t ob = g == 0 ? O_KVS0 : (g == 1 ? O_KVS1 : O_KVS2);
            *(f32x4*)(out + ob + (size_t)row * 1024 + 512 + h * 64 + c4) = v;
        } else if (t < 92) { const int c = 64 * (t - 72) + c4; *(f32x4*)(XBS + row * DR_ + c) = v;
            float* cs = out + O_CONVS + (size_t)row * 3 * DR_ + c; const float* sc = a->sconv + (size_t)row * 3 * DR_ + c;
            const f32x4 s0 = *(const f32x4*)sc, s1 = *(const f32x4*)(sc + DR_), s2 = *(const f32x4*)(sc + 2 * DR_);
            *(f32x4*)cs = s1; *(f32x4*)(cs + DR_) = s2; *(f32x4*)(cs + 2 * DR_) = v;
            const float* cw = a->convw + c; const f32x4 xc = *(const f32x4*)(a->convb + c) + s0 * *(const f32x4*)cw + s1 * *(const f32x4*)(cw + DR_) + s2 * *(const f32x4*)(cw + 2 * DR_) + v * *(const f32x4*)(cw + 3 * DR_);
            *(f32x4*)(XCF + row * DR_ + c) = xc; u32x2 w; w.x = cvt_pk_bf16(xc[0], xc[1]); w.y = cvt_pk_bf16(xc[2], xc[3]); *(u32x2*)(XCS + row * DR_ + c) = w;
        } else if (t < 112) { const int c = 64 * (t - 92) + c4;
#pragma unroll
            for (int e = 0; e < 4; ++e) v[e] = gelu_tanh_(v[e]);
            *(f32x4*)(GGS + row * DR_ + c) = v;
        } else { const bool isa = t < 128; const int c = 64 * (isa ? t - 112 : t - 128) + c4; const f32x4 b = *(const f32x4*)(a->bgate + (isa ? 0 : DM_) + c);
#pragma unroll
            for (int e = 0; e < 4; ++e) v[e] = sigmoidf_(v[e] + b[e]);
            *(f32x4*)((isa ? SAS : SBS) + row * DM_ + c) = v; }
    }
};
struct SEpiYa { const float* SAS; float* TMPS;
    __device__ __forceinline__ void rows(int t, int& b0, int& b1, int& acol) const { acol = 0; b0 = 64 * t; b1 = b0 + 32; }
    __device__ __forceinline__ void operator()(int t, const LAS float* red, int tid) const {
        const int row = tid >> 4, c = 64 * t + (tid & 15) * 4; const f32x4 v = *(const LAS f32x4*)(red + tid * 4);
        *(f32x4*)(TMPS + row * DM_ + c) = v * *(const f32x4*)(SAS + row * DM_ + c); }
};
struct SEpiYb { const float* SBS; const float* TMPS; bf16_t* MRGS;
    __device__ __forceinline__ void rows(int t, int& b0, int& b1, int& acol) const { acol = 0; b0 = 64 * t; b1 = b0 + 32; }
    __device__ __forceinline__ void operator()(int t, const LAS float* red, int tid) const {
        const int row = tid >> 4, c = 64 * t + (tid & 15) * 4; const f32x4 v = *(const LAS f32x4*)(red + tid * 4);
        const f32x4 y = *(const f32x4*)(TMPS + row * DM_ + c) + v * *(const f32x4*)(SBS + row * DM_ + c);
        u32x2 w; w.x = cvt_pk_bf16(y[0], y[1]); w.y = cvt_pk_bf16(y[2], y[3]); *(u32x2*)(MRGS + row * DM_ + c) = w; }
};
struct SEpiWout { const float* xs; const float* g2; float* X1S; bf16_t* A2S; float* SSQS;
    __device__ __forceinline__ void rows(int t, int& b0, int& b1, int& acol) const { acol = 0; b0 = 64 * t; b1 = b0 + 32; }
    __device__ __forceinline__ void operator()(int t, const LAS float* red, int tid) const {
        const int row = tid >> 4, c = 64 * t + (tid & 15) * 4; const f32x4 v = *(const LAS f32x4*)(red + tid * 4);
        const f32x4 x1 = *(const f32x4*)(xs + row * DM_ + c) + v; *(f32x4*)(X1S + row * DM_ + c) = x1;
        const f32x4 y = x1 * *(const f32x4*)(g2 + c); u32x2 w; w.x = cvt_pk_bf16(y[0], y[1]); w.y = cvt_pk_bf16(y[2], y[3]); *(u32x2*)(A2S + row * DM_ + c) = w;
        float ss = (x1[0] * x1[0] + x1[1] * x1[1]) + (x1[2] * x1[2] + x1[3] * x1[3]);
        ss += __shfl_xor(ss, 1); ss += __shfl_xor(ss, 2); ss += __shfl_xor(ss, 4); ss += __shfl_xor(ss, 8);
        if ((tid & 15) == 0) SSQS[row * 16 + t] = ss; }
};
struct SEpiFfn1 { const float* SSQS; bf16_t* HIDS;
    __device__ __forceinline__ void rows(int t, int& b0, int& b1, int& acol) const { acol = 0; b0 = 256 * (t >> 2) + 32 * (t & 3); b1 = b0 + 128; }
    __device__ __forceinline__ void operator()(int t, const LAS float* red, int tid) const {
        const int row = tid >> 4, cp = (tid & 15) * 2;
        float ssum = 0.f;
#pragma unroll
        for (int i = 0; i < 16; ++i) ssum += SSQS[row * 16 + i];
        const float rstd = 1.0f / sqrtf(ssum * (1.0f / DM_) + RMS_EPS_);
        const float g0 = red[row * 64 + cp] * rstd, g1 = red[row * 64 + cp + 1] * rstd, u0 = red[row * 64 + 32 + cp] * rstd, u1 = red[row * 64 + 32 + cp + 1] * rstd;
        *(unsigned*)(HIDS + row * DFF_ + 128 * (t >> 2) + 32 * (t & 3) + cp) = cvt_pk_bf16(g0 * sigmoidf_(g0) * u0, g1 * sigmoidf_(g1) * u1); }
};
struct SEpiOut { const float* X1S; float* YS;
    __device__ __forceinline__ void rows(int t, int& b0, int& b1, int& acol) const { acol = 0; b0 = 64 * t; b1 = b0 + 32; }
    __device__ __forceinline__ void operator()(int t, const LAS float* red, int tid) const {
        const int row = tid >> 4, c = 64 * t + (tid & 15) * 4; const f32x4 v = *(const LAS f32x4*)(red + tid * 4);
        *(f32x4*)(YS + row * DM_ + c) = *(const f32x4*)(X1S + row * DM_ + c) + v; }
};

__device__ __forceinline__ void lru_ab(float racc, float iacc, float brg, float big, float c8, float xcv, float& av, float& bv) {
    const float rr = sigmoidf_(racc + brg), ii = sigmoidf_(iacc + big), la = c8 * rr;
    av = __builtin_amdgcn_exp2f(la * LOG2E_);
    const float x2 = 2.0f * la;
    const float ser = -(x2 * (1.0f + x2 * (0.5f + x2 * (0.16666667f + x2 * (0.041666668f + x2 * (0.0083333338f + x2 * 0.0013888889f))))));
    const float em = x2 > -0.25f ? ser : 1.0f - av * av;
    bv = __builtin_amdgcn_sqrtf(em) * ii * xcv;
}
struct SEpiRnn { const Args* a; const float* XCF; const float* GGS; bf16_t* HBS;
    __device__ __forceinline__ void rows(int t, int& b0, int& b1, int& acol) const { acol = 128 * (t >> 2); b0 = 256 * (t >> 2) + 32 * (t & 3); b1 = b0 + 128; }
    __device__ __forceinline__ void operator()(int t, const LAS float* red, int tid) const {
        const int row = tid >> 4, cp = (tid & 15) * 2;
#pragma unroll
        for (int e = 0; e < 2; ++e) { const int ch = 128 * (t >> 2) + 32 * (t & 3) + cp + e;
            const float c8 = -8.0f * log1pf(expf(-a->lam[ch])); float av, bv;
            lru_ab(red[row * 64 + cp + e], red[row * 64 + 32 + cp + e], a->b_rg[ch], a->b_ig[ch], c8, XCF[row * DR_ + ch], av, bv);
            const float hn = av * a->sh[row * DR_ + ch] + bv;
            a->out[O_HS + row * DR_ + ch] = hn;
            HBS[row * DR_ + ch] = (bf16_t)(cvt_pk_bf16(hn * GGS[row * DR_ + ch], 0.f) & 0xffffu); }
    }
};

constexpr int AT_PITCH = 144, AT_VOFF = 384 * AT_PITCH;
typedef short v4i16_t __attribute__((ext_vector_type(4)));
struct AttnRegs { u32x4 kv[6], vv[6]; bf16x8 qf[4]; };
__device__ __forceinline__ void attn_decode(int u, int& g, int& h, int& dsh, int& res, int& qb) { g = u >> 9; h = (u >> 6) & 7; const int rem = u & 63; dsh = 2 * g; res = rem >> (6 - dsh); qb = rem & ((64 >> dsh) - 1); }
__device__ __forceinline__ void attn_issue(int u, const bf16_t* Q, const bf16_t* K, const bf16_t* V, AttnRegs& R) {
    const int tid = threadIdx.x, lane = tid & 63, wid = tid >> 6, r32 = lane & 31, h2 = lane >> 5;
    int g, h, dsh, res, qb; attn_decode(u, g, h, dsh, res, qb);
    const int hc = (8 * g + h) * 64, m0 = 256 * qb - 128;
#pragma unroll
    for (int i = 0; i < 6; ++i) { const int id = tid + 512 * i, key = id >> 3, ch = id & 7, mk = m0 + key;
        R.kv[i] = (u32x4){0u, 0u, 0u, 0u}; R.vv[i] = R.kv[i];
        if (mk >= 0) { const size_t off = (size_t)((mk << dsh) + res) * QKV_ + hc + ch * 8; R.kv[i] = *(const u32x4*)(K + off); R.vv[i] = *(const u32x4*)(V + off); } }
    const int qi = 32 * wid + r32; const size_t tq = (size_t)(((256 * qb + qi) << dsh) + res);
#pragma unroll
    for (int ks = 0; ks < 4; ++ks) R.qf[ks] = *(const bf16x8*)(Q + tq * QKV_ + hc + 16 * ks + 8 * h2);
}
__device__ __forceinline__ void attn_stage(LAS unsigned char* lds, const AttnRegs& R) {
    const int tid = threadIdx.x;
#pragma unroll
    for (int i = 0; i < 6; ++i) { const int id = tid + 512 * i, key = id >> 3, ch = id & 7;
        *(LAS u32x4*)(lds + key * AT_PITCH + ch * 16) = R.kv[i]; *(LAS u32x4*)(lds + AT_VOFF + key * AT_PITCH + ch * 16) = R.vv[i]; }
}
__device__ __forceinline__ void attn_compute(LAS unsigned char* lds, int u, const bf16x8 (&qf)[4], bf16_t* OG, float* ST) {
    const int tid = threadIdx.x, lane = tid & 63, wid = __builtin_amdgcn_readfirstlane(tid >> 6), r32 = lane & 31, h2 = lane >> 5;
    int g, h, dsh, res, qb; attn_decode(u, g, h, dsh, res, qb);
    const int qi = 32 * wid + r32; const size_t tq = (size_t)(((256 * qb + qi) << dsh) + res);
    f32x16 s[5];
#pragma unroll
    for (int kt = 0; kt < 5; ++kt) {
#pragma unroll
        for (int i = 0; i < 16; ++i) s[kt][i] = 0.f;
#pragma unroll
        for (int ks = 0; ks < 4; ++ks) { const bf16x8 kf = *(const LAS bf16x8*)(lds + (32 * wid + 32 * kt + r32) * AT_PITCH + (16 * ks + 8 * h2) * 2);
            s[kt] = __builtin_amdgcn_mfma_f32_32x32x16_bf16(kf, qf[ks], s[kt], 0, 0, 0); }
    }
#pragma unroll
    for (int r = 0; r < 16; ++r) { const int k0 = (r & 3) + 8 * (r >> 2) + 4 * h2; if (k0 < r32) s[0][r] = -1e30f; if (k0 > r32) s[4][r] = -1e30f; }
    if (qb == 0) {
#pragma unroll
        for (int kt = 0; kt < 5; ++kt)
#pragma unroll
            for (int r = 0; r < 16; ++r) { const int kk = 32 * wid + 32 * kt + (r & 3) + 8 * (r >> 2) + 4 * h2; if (kk < 128) s[kt][r] = -1e30f; }
    }
    float mx = -1e30f;
#pragma unroll
    for (int kt = 0; kt < 5; ++kt)
#pragma unroll
        for (int r = 0; r < 16; ++r) mx = fmaxf(mx, s[kt][r]);
    mx = fmaxf(mx, __shfl_xor(mx, 32));
    float den = 0.f;
#pragma unroll
    for (int kt = 0; kt < 5; ++kt)
#pragma unroll
        for (int r = 0; r < 16; ++r) { const float p = __builtin_amdgcn_exp2f(s[kt][r] - mx); s[kt][r] = p; den += p; }
    den += __shfl_xor(den, 32);
    f32x16 o[2];
#pragma unroll
    for (int i = 0; i < 16; ++i) { o[0][i] = 0.f; o[1][i] = 0.f; }
    const LAS unsigned char* vbase = lds + AT_VOFF + (32 * wid + 4 * h2 + ((lane & 15) >> 2)) * AT_PITCH + (16 * ((lane >> 4) & 1) + 4 * (lane & 3)) * 2;
#pragma unroll
    for (int kt = 0; kt < 5; ++kt)
#pragma unroll
        for (int s2 = 0; s2 < 2; ++s2) {
            u32x4 pw; pw.x = cvt_pk_bf16(s[kt][8 * s2 + 0], s[kt][8 * s2 + 1]); pw.y = cvt_pk_bf16(s[kt][8 * s2 + 2], s[kt][8 * s2 + 3]);
            pw.z = cvt_pk_bf16(s[kt][8 * s2 + 4], s[kt][8 * s2 + 5]); pw.w = cvt_pk_bf16(s[kt][8 * s2 + 6], s[kt][8 * s2 + 7]);
            const bf16x8 pb = __builtin_bit_cast(bf16x8, pw);
#pragma unroll
            for (int dt = 0; dt < 2; ++dt) {
                const LAS unsigned char* vp = vbase + (32 * kt + 16 * s2) * AT_PITCH + 64 * dt;
                const v4i16_t lo = __builtin_amdgcn_ds_read_tr16_b64_v4i16((LAS v4i16_t*)vp), hi = __builtin_amdgcn_ds_read_tr16_b64_v4i16((LAS v4i16_t*)(vp + 8 * AT_PITCH));
                const bf16x8 va = (bf16x8){lo[0], lo[1], lo[2], lo[3], hi[0], hi[1], hi[2], hi[3]};
                o[dt] = __builtin_amdgcn_mfma_f32_32x32x16_bf16(va, pb, o[dt], 0, 0, 0);
            }
        }
    const float rden = 1.0f / den;
    bf16_t* orow = OG + ((size_t)g * S_ + tq) * 512 + h * 64 + 4 * h2;
#pragma unroll
    for (int dt = 0; dt < 2; ++dt)
#pragma unroll
        for (int rg = 0; rg < 4; ++rg) { u32x2 w; w.x = cvt_pk_bf16(o[dt][4 * rg] * rden, o[dt][4 * rg + 1] * rden); w.y = cvt_pk_bf16(o[dt][4 * rg + 2] * rden, o[dt][4 * rg + 3] * rden);
            *(u32x2*)(orow + 32 * dt + 8 * rg) = w; }
    if (h2 == 0) *(f32x2*)(ST + (((size_t)g * S_ + tq) * 8 + h) * 2) = (f32x2){mx, den};
}
__device__ __forceinline__ void attn_phase(LAS unsigned char* lds, int blk, int G, const bf16_t* Q, const bf16_t* K, const bf16_t* V, bf16_t* OG, float* ST) {
    AttnRegs R; int u = blk;
    if (u < 1536) attn_issue(u, Q, K, V, R);
    for (; u < 1536; u += G) {
        attn_stage(lds, R);
        bf16x8 qc[4];
#pragma unroll
        for (int ks = 0; ks < 4; ++ks) qc[ks] = R.qf[ks];
        __syncthreads();
        if (u + G < 1536) attn_issue(u + G, Q, K, V, R);
        attn_compute(lds, u, qc, OG, ST);
        __syncthreads();
    }
}
__device__ __forceinline__ void attn_combine(const bf16_t* OG, const float* ST, bf16_t* ATT, int blk, int G) {
    const int gt = blk * NTHREADS + threadIdx.x, NT = G * NTHREADS;
    for (int i0 = gt; i0 < S_ * 64; i0 += 4 * NT) {
        f32x2 st[4][3]; u32x4 og[4][3];
#pragma unroll
        for (int k = 0; k < 4; ++k) { const int i = (i0 + k * NT) < S_ * 64 ? (i0 + k * NT) : i0; const int t = i >> 6, h = (i >> 3) & 7, c8 = i & 7;
#pragma unroll
            for (int g = 0; g < 3; ++g) { st[k][g] = *(const f32x2*)(ST + (((size_t)g * S_ + t) * 8 + h) * 2); og[k][g] = *(const u32x4*)(OG + ((size_t)g * S_ + t) * 512 + h * 64 + c8 * 8); } }
#pragma unroll
        for (int k = 0; k < 4; ++k) { const int i = i0 + k * NT; if (i < S_ * 64) { const int t = i >> 6, h = (i >> 3) & 7, c8 = i & 7;
            const float M = fmaxf(st[k][0][0], fmaxf(st[k][1][0], st[k][2][0]));
            float w[3], wsum = 0.f;
#pragma unroll
            for (int g = 0; g < 3; ++g) { w[g] = st[k][g][1] * __builtin_amdgcn_exp2f(st[k][g][0] - M); wsum += w[g]; }
            const float rw = 1.0f / wsum;
            f32x4 a0 = (f32x4){0.f, 0.f, 0.f, 0.f}, a1 = a0;
#pragma unroll
            for (int g = 0; g < 3; ++g) { f32x4 x0, x1; unpack8(og[k][g], x0, x1); a0 += x0 * (w[g] * rw); a1 += x1 * (w[g] * rw); }
            *(u32x4*)(ATT + (size_t)t * 512 + h * 64 + c8 * 8) = pack8(a0, a1); } }
    }
}

constexpr int XC_PITCH = 136;
struct RnnRegs { u32x4 xr[7]; };
__device__ __forceinline__ void rnn_issue(int u, const bf16_t* XB, const bf16_t* GG, RnnRegs& R) {
    const int tid = threadIdx.x; const int c = u / 10, n = u - 10 * c;
    const int co = tid & 15, tg = tid >> 4, ch0 = n * 128 + 8 * co, t0 = 128 * c + 4 * tg;
#pragma unroll
    for (int i = 0; i < 7; ++i) { const int tt = t0 - 3 + i; R.xr[i] = (u32x4){0u, 0u, 0u, 0u}; if (tt >= 0) R.xr[i] = *(const u32x4*)(XB + (size_t)tt * DR_ + ch0); }
}
__device__ __forceinline__ void rnn_unit(LAS unsigned char* lds, int u, int unext, const Args& a, const bf16_t* XB, const bf16_t* GG, const bf16_t* WG, float* AGG, bf16_t* HLG, bf16_t* PCG, RnnRegs& R) {
    const int tid = threadIdx.x, lane = tid & 63, wid = __builtin_amdgcn_readfirstlane(tid >> 6), r32 = lane & 31, h2 = lane >> 5;
    const int c = u / 10, n = u - 10 * c;
    LAS float* A_s = (LAS float*)lds; LAS float* B_s = A_s + 16384; LAS bf16_t* XC = (LAS bf16_t*)lds;
    LAS f32x2* SEG = (LAS f32x2*)(lds + MISC_OFF);
    const int cwv = wid & 3, rh = wid >> 2;
    bf16x8 wfr[8], wfi[8];
    {   const bf16_t* wrp = WG + (size_t)(n * 256 + 32 * cwv + r32) * 128 + 8 * h2; const bf16_t* wip = wrp + 128 * 128;
#pragma unroll
        for (int ks = 0; ks < 8; ++ks) { wfr[ks] = *(const bf16x8*)(wrp + 16 * ks); wfi[ks] = *(const bf16x8*)(wip + 16 * ks); } }
    {
        const int co = tid & 15, tg = tid >> 4, ch0 = n * 128 + 8 * co;
        f32x4 cw[4][2], cb[2];
#pragma unroll
        for (int j = 0; j < 4; ++j) { cw[j][0] = *(const f32x4*)(a.convw + j * DR_ + ch0); cw[j][1] = *(const f32x4*)(a.convw + j * DR_ + ch0 + 4); }
        cb[0] = *(const f32x4*)(a.convb + ch0); cb[1] = *(const f32x4*)(a.convb + ch0 + 4);
        f32x4 x[7][2];
#pragma unroll
        for (int i = 0; i < 7; ++i) unpack8(R.xr[i], x[i][0], x[i][1]);
#pragma unroll
        for (int k = 0; k < 4; ++k) { f32x4 y0 = cb[0], y1 = cb[1];
#pragma unroll
            for (int j = 0; j < 4; ++j) { y0 += cw[j][0] * x[k + j][0]; y1 += cw[j][1] * x[k + j][1]; }
            *(LAS u32x4*)(XC + (4 * tg + k) * XC_PITCH + 8 * co) = pack8(y0, y1); }
    }
    __syncthreads();
    f32x16 ar[2], ai[2];
#pragma unroll
    for (int i = 0; i < 16; ++i) { ar[0][i] = 0.f; ar[1][i] = 0.f; ai[0][i] = 0.f; ai[1][i] = 0.f; }
#pragma unroll
    for (int ks = 0; ks < 8; ++ks) {
#pragma unroll
        for (int rt = 0; rt < 2; ++rt) { const bf16x8 av = *(const LAS bf16x8*)(XC + (64 * rh + 32 * rt + r32) * XC_PITCH + 16 * ks + 8 * h2);
            ar[rt] = __builtin_amdgcn_mfma_f32_32x32x16_bf16(av, wfr[ks], ar[rt], 0, 0, 0); ai[rt] = __builtin_amdgcn_mfma_f32_32x32x16_bf16(av, wfi[ks], ai[rt], 0, 0, 0); } }
    if (unext < 1280) rnn_issue(unext, XB, GG, R);
    u32x4 ggv[4];
#pragma unroll
    for (int i = 0; i < 4; ++i) { const int item = tid + 512 * i, t = item >> 4, c8i = item & 15; ggv[i] = *(const u32x4*)(GG + (size_t)(128 * c + t) * DR_ + n * 128 + 8 * c8i); }
    {   const int chl = 32 * cwv + r32, chg = n * 128 + chl;
        const float brg = a.b_rg[chg], big = a.b_ig[chg], c8 = -8.0f * log1pf(expf(-a.lam[chg]));
#pragma unroll
        for (int rt = 0; rt < 2; ++rt)
#pragma unroll
            for (int r = 0; r < 16; ++r) { const int tl = 64 * rh + 32 * rt + (r & 3) + 8 * (r >> 2) + 4 * h2;
                const float xcv = bf2f(XC[tl * XC_PITCH + chl]);
                float av, bv; lru_ab(ar[rt][r], ai[rt][r], brg, big, c8, xcv, av, bv); ar[rt][r] = av; ai[rt][r] = bv; }
        __syncthreads();
#pragma unroll
        for (int rt = 0; rt < 2; ++rt)
#pragma unroll
            for (int r = 0; r < 16; ++r) { const int tl = 64 * rh + 32 * rt + (r & 3) + 8 * (r >> 2) + 4 * h2; A_s[tl * 128 + chl] = ar[rt][r]; B_s[tl * 128 + chl] = ai[rt][r]; }
    }
    __syncthreads();
    {   const int ch = tid & 127, seg = tid >> 7;
        float Ap = 1.f, Bp = 0.f;
#pragma unroll 8
        for (int k = 0; k < 32; ++k) { const float av = A_s[(32 * seg + k) * 128 + ch], bv = B_s[(32 * seg + k) * 128 + ch]; Bp = av * Bp + bv; Ap *= av; }
        SEG[seg * 128 + ch] = (f32x2){Ap, Bp};
        __syncthreads();
        float hcur = 0.f, pcur = 1.f;
        for (int q = 0; q < seg; ++q) { const f32x2 sg = SEG[q * 128 + ch]; hcur = sg[0] * hcur + sg[1]; pcur *= sg[0]; }
#pragma unroll 8
        for (int k = 0; k < 32; ++k) { const int idx = (32 * seg + k) * 128 + ch; const float av = A_s[idx], bv = B_s[idx]; hcur = av * hcur + bv; pcur *= av; A_s[idx] = pcur; B_s[idx] = hcur; }
        if (seg == 3) *(f32x2*)(AGG + ((size_t)c * DR_ + n * 128 + ch) * 2) = (f32x2){pcur, hcur};
    }
    __syncthreads();
#pragma unroll
    for (int i = 0; i < 4; ++i) { const int item = tid + 512 * i, t = item >> 4, c8i = item & 15;
        const f32x4 p0 = *(const LAS f32x4*)(A_s + t * 128 + 8 * c8i), p1 = *(const LAS f32x4*)(A_s + t * 128 + 8 * c8i + 4);
        const f32x4 h0 = *(const LAS f32x4*)(B_s + t * 128 + 8 * c8i), h1 = *(const LAS f32x4*)(B_s + t * 128 + 8 * c8i + 4);
        f32x4 g0, g1; unpack8(ggv[i], g0, g1);
        const size_t off = (size_t)(128 * c + t) * DR_ + n * 128 + 8 * c8i;
        *(u32x4*)(HLG + off) = pack8(h0 * g0, h1 * g1); *(u32x4*)(PCG + off) = pack8(p0 * g0, p1 * g1); }
    __syncthreads();
}
__device__ __forceinline__ void rnn_fix_phase(LAS unsigned char* lds, int blk, int G, const Args& a, const float* AGG, const bf16_t* HLG, const bf16_t* PCG, bf16_t* HB) {
    const int tid = threadIdx.x;
    LAS f32x2* CAR = (LAS f32x2*)lds; LAS float* HIN = (LAS float*)(lds + 32768);
    for (int ub = blk; ub < 1280; ub += 5 * G) {
        {   const int ch = tid & 127, q = tid >> 7;
#pragma unroll
            for (int i = 0; i < 5; ++i) { const int u = ub + i * G; if (u < 1280) { const int c = u / 10, n = u - 10 * c, lo = (c * q) >> 2, hi = (c * (q + 1)) >> 2;
                float Ap = 1.f, Bp = 0.f;
#pragma unroll 4
                for (int k = lo; k < hi; ++k) { const f32x2 ab = *(const f32x2*)(AGG + ((size_t)k * DR_ + n * 128 + ch) * 2); Bp = ab[0] * Bp + ab[1]; Ap *= ab[0]; }
                CAR[(i * 4 + q) * 128 + ch] = (f32x2){Ap, Bp}; } }
        }
        __syncthreads();
        for (int j = tid; j < 5 * 128; j += NTHREADS) { const int i = j >> 7, ch = j & 127, u = ub + i * G;
            if (u < 1280) { const int c = u / 10, n = u - 10 * c; float hin = 0.f;
#pragma unroll
                for (int q = 0; q < 4; ++q) { const f32x2 cg = CAR[(i * 4 + q) * 128 + ch]; hin = cg[0] * hin + cg[1]; }
                HIN[j] = hin;
                if (c == 127) { const f32x2 ab = *(const f32x2*)(AGG + ((size_t)127 * DR_ + n * 128 + ch) * 2); a.out[O_HP + n * 128 + ch] = ab[0] * hin + ab[1]; } } }
        __syncthreads();
#pragma unroll 1
        for (int i = 0; i < 5; ++i) { const int u = ub + i * G; if (u >= 1280) break; const int c = u / 10, n = u - 10 * c;
            u32x4 hv[4], pv[4];
#pragma unroll
            for (int k = 0; k < 4; ++k) { const int item = tid + 512 * k, t = item >> 4, c8i = item & 15; const size_t off = (size_t)(128 * c + t) * DR_ + n * 128 + 8 * c8i;
                hv[k] = *(const u32x4*)(HLG + off); pv[k] = *(const u32x4*)(PCG + off); }
#pragma unroll
            for (int k = 0; k < 4; ++k) { const int item = tid + 512 * k, t = item >> 4, c8i = item & 15; const size_t off = (size_t)(128 * c + t) * DR_ + n * 128 + 8 * c8i;
                const f32x4 i0 = *(const LAS f32x4*)(HIN + i * 128 + 8 * c8i), i1 = *(const LAS f32x4*)(HIN + i * 128 + 8 * c8i + 4);
                f32x4 h0, h1, p0, p1; unpack8(hv[k], h0, h1); unpack8(pv[k], p0, p1);
                *(u32x4*)(HB + off) = pack8(h0 + p0 * i0, h1 + p1 * i1); } }
        __syncthreads();
    }
}

__device__ __forceinline__ void sample_attn_item(int it, const Args& a, const float* QS, float* OGS, float* STS) {
    const int lane = threadIdx.x & 63;
    const int sp = it & 3, bgh = it >> 2, b = bgh / 24, gh = bgh - 24 * b, g = gh >> 3, h = gh & 7;
    const int L = 128 << (2 * g), d = 1 << (2 * g), j0 = 33 * sp;
    const float* cache = (g == 0 ? a.c128 : (g == 1 ? a.c512 : a.c2048)) + (size_t)b * L * 1024 + h * 64;
    const float* knew = a.out + (g == 0 ? O_KVS0 : (g == 1 ? O_KVS1 : O_KVS2)) + (size_t)b * 1024 + h * 64;
    const int ks = lane >> 2, part = lane & 3;
    f32x4 q[4];
#pragma unroll
    for (int i = 0; i < 4; ++i) q[i] = *(const f32x4*)(QS + b * QKV_ + (8 * g + h) * 64 + 16 * part + 4 * i);
    float sc[3]; float mx = -1e30f;
#pragma unroll
    for (int i3 = 0; i3 < 3; ++i3) {
        const int jl = 16 * i3 + ks, j = j0 + jl; const bool valid = jl < 33 && j <= 128; const int jj = valid ? j : j0 + 1;
        const float* kp = (jj == 0) ? knew : cache + (size_t)(L - d * jj) * 1024;
        float dot = 0.f;
#pragma unroll
        for (int i = 0; i < 4; ++i) { const f32x4 kv = *(const f32x4*)(kp + 16 * part + 4 * i); dot += (q[i][0] * kv[0] + q[i][1] * kv[1]) + (q[i][2] * kv[2] + q[i][3] * kv[3]); }
        dot += __shfl_xor(dot, 1); dot += __shfl_xor(dot, 2);
        sc[i3] = valid ? dot : -1e30f; mx = fmaxf(mx, sc[i3]);
    }
    mx = fmaxf(mx, __shfl_xor(mx, 4)); mx = fmaxf(mx, __shfl_xor(mx, 8)); mx = fmaxf(mx, __shfl_xor(mx, 16)); mx = fmaxf(mx, __shfl_xor(mx, 32));
    float den = 0.f;
#pragma unroll
    for (int i3 = 0; i3 < 3; ++i3) { sc[i3] = __builtin_amdgcn_exp2f(sc[i3] - mx); den += sc[i3]; }
    den += __shfl_xor(den, 4); den += __shfl_xor(den, 8); den += __shfl_xor(den, 16); den += __shfl_xor(den, 32);
    const int kq = lane >> 4, dq = lane & 15;
    f32x4 acc = (f32x4){0.f, 0.f, 0.f, 0.f};
#pragma unroll
    for (int i2 = 0; i2 < 9; ++i2) {
        const int jl = 4 * i2 + kq, j = j0 + jl; const bool valid = jl < 33 && j <= 128; const int jj = valid ? j : j0 + 1;
        float p = __shfl(sc[i2 >> 2], (jl & 15) << 2); if (!valid) p = 0.f;
        const float* vp = ((jj == 0) ? knew : cache + (size_t)(L - d * jj) * 1024) + 512;
        const f32x4 vv = *(const f32x4*)(vp + 4 * dq);
        acc += vv * p;
    }
#pragma unroll
    for (int e = 0; e < 4; ++e) { acc[e] += __shfl_xor(acc[e], 16); acc[e] += __shfl_xor(acc[e], 32); }
    const int pi = (b * 12 + g * 4 + sp);
    if (kq == 0) *(f32x4*)(OGS + pi * 512 + h * 64 + 4 * dq) = acc * (1.0f / den);
    if (lane == 0) *(f32x2*)(STS + (pi * 8 + h) * 2) = (f32x2){mx, den};
}
__device__ __forceinline__ void sample_combine(const float* OGS, const float* STS, bf16_t* ATTS, int blk) {
    const int i = blk * NTHREADS + threadIdx.x;
    if (i < NBS * 512) { const int b = i >> 9, cidx = i & 511, h = cidx >> 6;
        f32x2 st[12]; float M = -1e30f;
#pragma unroll
        for (int p = 0; p < 12; ++p) { st[p] = *(const f32x2*)(STS + ((b * 12 + p) * 8 + h) * 2); M = fmaxf(M, st[p][0]); }
        float num = 0.f, wsum = 0.f;
#pragma unroll
        for (int p = 0; p < 12; ++p) { const float w = st[p][1] * __builtin_amdgcn_exp2f(st[p][0] - M); wsum += w; num += w * OGS[(b * 12 + p) * 512 + cidx]; }
        ATTS[b * 512 + cidx] = (bf16_t)(cvt_pk_bf16(num / wsum, 0.f) & 0xffffu); }
}

__global__ void __launch_bounds__(NTHREADS, 2) fwd_mega(Args a) {
    extern __shared__ __attribute__((aligned(16))) unsigned char lds_raw[];
    LAS unsigned char* lds = (LAS unsigned char*)lds_raw;
    cg::grid_group grid = cg::this_grid();
    const int G = gridDim.x, blk = blockIdx.x, tid = threadIdx.x, wid = tid >> 6;
    unsigned char* ws = a.ws; float* out = a.out;
    bf16_t *WIN = (bf16_t*)(ws + WS_WIN), *WG = (bf16_t*)(ws + WS_WG), *WOA = (bf16_t*)(ws + WS_WOA), *WOB = (bf16_t*)(ws + WS_WOB), *WOUT = (bf16_t*)(ws + WS_WOUT), *WF1 = (bf16_t*)(ws + WS_WFF1), *WF2 = (bf16_t*)(ws + WS_WFF2);
    bf16_t *HN = (bf16_t*)(ws + WS_HN), *Qb = (bf16_t*)(ws + WS_Q), *Kb = (bf16_t*)(ws + WS_K), *Vb = (bf16_t*)(ws + WS_V), *XB = (bf16_t*)(ws + WS_XB), *GG = (bf16_t*)(ws + WS_GG), *SA = (bf16_t*)(ws + WS_SA), *SB = (bf16_t*)(ws + WS_SB);
    bf16_t *TMP = (bf16_t*)(ws + WS_TMP), *OG = (bf16_t*)(ws + WS_OG), *ATT = (bf16_t*)(ws + WS_ATT), *HB = (bf16_t*)(ws + WS_HB), *MRG = (bf16_t*)(ws + WS_MRG), *A2 = (bf16_t*)(ws + WS_A2), *HID = (bf16_t*)(ws + WS_HID);
    float *ST = (float*)(ws + WS_ST), *AGG = (float*)(ws + WS_AGG),  *SSQ = (float*)(ws + WS_SSQ);
    unsigned char* sm = ws + WS_SMALL;
    float *QS = (float*)(sm + SM_QS * SM_STRIDE), *XBS = (float*)(sm + SM_XBS * SM_STRIDE), *GGS = (float*)(sm + SM_GGS * SM_STRIDE), *SAS = (float*)(sm + SM_SAS * SM_STRIDE), *SBS = (float*)(sm + SM_SBS * SM_STRIDE);
    float *OGS = (float*)(sm + SM_N * SM_STRIDE), *XCF = (float*)(sm + SM_XCF * SM_STRIDE), *STS = (float*)(sm + SM_STS * SM_STRIDE), *TMPS = (float*)(sm + SM_TMPS * SM_STRIDE), *X1S = (float*)(sm + SM_X1S * SM_STRIDE), *SSQS = (float*)(sm + SM_SSQS * SM_STRIDE);
    bf16_t *XCS = (bf16_t*)(sm + SM_XCS * SM_STRIDE), *ATTS = (bf16_t*)(sm + SM_ATTS * SM_STRIDE), *HBS = (bf16_t*)(sm + SM_HBS * SM_STRIDE), *MRGS = (bf16_t*)(sm + SM_MRGS * SM_STRIDE), *A2S = (bf16_t*)(sm + SM_A2S * SM_STRIDE), *HIDS = (bf16_t*)(sm + SM_HIDS * SM_STRIDE);
    bf16_t* HNS = HN + (size_t)S_ * DM_;
    bf16_t *HLG = (bf16_t*)(ws + WS_TMP), *PCG = (bf16_t*)(ws + WS_HID);
    const int lo = a.ph_lo, hi = a.ph_hi;
#define IN(k) (lo <= (k) && (k) < hi)
#define SEAM(k) do { if (IN(k) && IN((k) + 1)) xcd_barrier(bar); } while (0)
    if (tid < 4) ((LAS unsigned*)(lds + MISC_OFF + 12288))[tid] = 0u;
    __syncthreads();
    XcdBarrier bar = xcd_barrier_post((unsigned*)(ws + WS_CTL), (volatile LAS unsigned*)(lds + MISC_OFF + 12288));
    if (a.ph_hi > 1000) grid.sync();

    if (IN(0)) { p0_prologue<0>(a, lds, blk, G); }
    SEAM(0);
    if (IN(1)) {
        { SEpiIn E{&a, QS, XBS, GGS, SAS, SBS, XCS, XCF}; small_gemm<DM_, 8>(lds, HNS, DM_, WIN, 144, G, blk, E); }
        pg8::Gemm g{HN, WIN, S_, INW_, DM_}; pg8::StaticOrder S; S.init(S_, INW_, G, blk);
        pg8::EpiIn E{Qb, Kb, Vb, XB, GG, SA, SB, out, a.qg, a.kg, a.bgate};
        pg8::gemm_phase<pg8::EpiIn, pg8::StaticOrder, true, true>(lds, g, S, E);
    }
    SEAM(1);
    if (IN(2)) {
        const int gw = blk * NWAVES + wid, NGW = G * NWAVES;
        p0_prologue<1>(a, lds, blk, G); __syncthreads();
        { SEpiRnn E{&a, XCF, GGS, HBS}; small_gemm<128, 1>(lds, XCS, DR_, WG, 40, G, blk, E); }
        for (int it = gw; it < NBS * 24 * 4; it += NGW) sample_attn_item(it, a, QS, OGS, STS);
        __syncthreads();
        attn_phase(lds, blk, G, Qb, Kb, Vb, OG, ST);
        { RnnRegs R; if (blk < 1280) rnn_issue(blk, XB, GG, R);
          for (int u = blk; u < 1280; u += G) rnn_unit(lds, u, u + G, a, XB, GG, WG, AGG, HLG, PCG, R); }
    }
    SEAM(2);
    if (IN(3)) {
        sample_combine(OGS, STS, ATTS, blk);
        rnn_fix_phase(lds, blk, G, a, AGG, HLG, PCG, HB);
        attn_combine(OG, ST, ATT, blk, G);
    }
    SEAM(3);
    if (IN(4)) {
        { SEpiYa E{SAS, TMPS}; small_gemm<512, 4>(lds, ATTS, 512, WOA, 16, G, blk, E); }
        { SEpiYb E{SBS, TMPS, MRGS}; small_gemm<DR_, 10>(lds, HBS, DR_, WOB, 16, G, blk, E); }
        { pg8::Gemm g{ATT, WOA, S_, DM_, 512}; pg8::StaticOrder S; S.init(S_, DM_, G, blk); pg8::EpiYa E{SA, TMP};
          pg8::gemm_phase<pg8::EpiYa, pg8::StaticOrder, true, true>(lds, g, S, E); }
        { pg8::Gemm g{HB, WOB, S_, DM_, DR_}; pg8::StaticOrder S; S.init(S_, DM_, G, blk); pg8::EpiYb E{SB, TMP, MRG};
          pg8::gemm_phase<pg8::EpiYb, pg8::StaticOrder, true, true>(lds, g, S, E); }
    }
    SEAM(4);
    if (IN(5)) {
        { SEpiWout E{a.xs, a.n2g, X1S, A2S, SSQS}; small_gemm<DM_, 8>(lds, MRGS, DM_, WOUT, 16, G, blk, E); }
        pg8::Gemm g{MRG, WOUT, S_, DM_, DM_}; pg8::StaticOrder S; S.init(S_, DM_, G, blk); pg8::EpiWout E{a.x, out + O_YP, A2, SSQ, a.n2g};
        pg8::gemm_phase<pg8::EpiWout, pg8::StaticOrder, true, true>(lds, g, S, E);
    }
    SEAM(5);
    if (IN(6)) {
        { SEpiFfn1 E{SSQS, HIDS}; small_gemm<DM_, 8>(lds, A2S, DM_, WF1, 88, G, blk, E); }
        pg8::Gemm g{A2, WF1, S_, 2 * DFF_, DM_}; pg8::StaticOrder S; S.init(S_, 2 * DFF_, G, blk); pg8::EpiFfn1 E{SSQ, HID};
        pg8::gemm_phase<pg8::EpiFfn1, pg8::StaticOrder, true, true>(lds, g, S, E);
    }
    SEAM(6);
    if (IN(7)) {
        { SEpiOut E{X1S, out + O_YS}; small_gemm<DFF_, 11>(lds, HIDS, DFF_, WF2, 16, G, blk, E); }
        pg8::Gemm g{HID, WF2, S_, DM_, DFF_}; pg8::StaticOrder S; S.init(S_, DM_, G, blk); pg8::EpiOut E{out + O_YP};
        pg8::gemm_phase<pg8::EpiOut, pg8::StaticOrder, true, true>(lds, g, S, E);
    }
#undef IN
#undef SEAM
}

extern "C" void kernel_launch(void* const* d_in, const int* in_sizes, int n_in, void* d_out, int out_size, void* d_ws, size_t ws_size, hipStream_t stream) {
    static int grid = 0;
    if (grid == 0) {
        if (n_in != 25 || in_sizes[0] != S_ * DM_ || (size_t)out_size != O_END || ws_size < WS_END) {
            fprintf(stderr, "kernel_launch: unexpected shapes: n_in %d in0 %d out %d ws %zu (need >= %zu); nothing launched\n", n_in, n_in > 0 ? in_sizes[0] : -1, out_size, ws_size, (size_t)WS_END); grid = -1; return; }
        int dev = 0, cus = 0, per_cu = 0;
        if (hipGetDevice(&dev) != hipSuccess || hipDeviceGetAttribute(&cus, hipDeviceAttributeMultiprocessorCount, dev) != hipSuccess) { grid = -1; return; }
        if (hipFuncSetAttribute((const void*)fwd_mega, hipFuncAttributeMaxDynamicSharedMemorySize, LDS_BYTES) != hipSuccess) { fprintf(stderr, "kernel_launch: hipFuncSetAttribute failed\n"); grid = -1; return; }
        if (hipOccupancyMaxActiveBlocksPerMultiprocessor(&per_cu, (const void*)fwd_mega, NTHREADS, LDS_BYTES) != hipSuccess || per_cu < 1) { fprintf(stderr, "kernel_launch: occupancy query says %d blocks per CU\n", per_cu); per_cu = 1; }
        (void)hipGetLastError();
        grid = cus * per_cu;
    }
    if (grid < 0) return;
    if (hipMemsetAsync((char*)d_ws + WS_CTL, 0, CTL_ZERO_BYTES, stream) != hipSuccess) { fprintf(stderr, "kernel_launch: memset failed\n"); return; }
    Args a{};
    const float** f = (const float**)&a;
    for (int i = 0; i < 25; ++i) f[i] = (const float*)d_in[i];
    a.out = (float*)d_out; a.ws = (unsigned char*)d_ws;
#if MK_MULTI
    for (int p = 0; p < 8; ++p) { a.ph_lo = p; a.ph_hi = p + 1; hipLaunchKernelGGL(fwd_mega, dim3(grid), dim3(NTHREADS), LDS_BYTES, stream, a); }
#else
    a.ph_lo = 0; a.ph_hi = 8;
    void* args[] = {&a};
    const hipError_t e = hipLaunchCooperativeKernel((const void*)fwd_mega, dim3(grid), dim3(NTHREADS), args, LDS_BYTES, stream);
    if (e != hipSuccess) fprintf(stderr, "kernel_launch: cooperative launch failed: %s (grid %d)\n", hipGetErrorString(e), grid);
#endif
}
```

```cpp
#include <hip/hip_runtime.h>
#include <hip/hip_cooperative_groups.h>
#include <cstdio>
#include <cstdint>
namespace cg = cooperative_groups;

#ifndef MK_MULTI
#define MK_MULTI 0
#endif


constexpr int S_ = 16384, DM_ = 1024, NBS = 32, QKV_ = 1536, DR_ = 1280, DFF_ = 2816, INW_ = 9216;
constexpr int KCAT_ = 512 + 1280;
constexpr int LDH_ = DFF_ + 64;
constexpr float RMS_EPS_ = 1e-6f, LOG2E_ = 1.4426950408889634f, QSCALE_ = 0.125f * 1.4426950408889634f;
constexpr size_t O_YP = 0, O_YS = 16777216, O_KVP0 = 16809984, O_KVP1 = 16941056, O_KVP2 = 17465344, O_CONVP = 19562496, O_HP = 19566336,
                 O_KVS0 = 19567616, O_KVS1 = 19600384, O_KVS2 = 19633152, O_CONVS = 19665920, O_HS = 19788800, O_END = 19829760;
constexpr size_t MiB_ = 1u << 20;
constexpr size_t WS_WIN = 0, WS_WG = 18 * MiB_, WS_WOA = 19 * MiB_, WS_WOB = 20 * MiB_, WS_WOUT = 23 * MiB_, WS_WFF1 = 25 * MiB_, WS_WFF2 = 36 * MiB_, WS_SMALL = 42 * MiB_,
                 WS_HN = 48 * MiB_, WS_Q = 81 * MiB_, WS_K = 129 * MiB_, WS_V = 177 * MiB_, WS_XB = 225 * MiB_, WS_GG = 265 * MiB_, WS_SA = 305 * MiB_, WS_SB = 337 * MiB_,
                 WS_OG = 369 * MiB_, WS_ST = 417 * MiB_, WS_ATT = 420 * MiB_, WS_AGG = 436 * MiB_, WS_HB = 438 * MiB_, WS_TMP = 478 * MiB_, WS_MRG = 542 * MiB_, WS_A2 = 574 * MiB_,
                 WS_SSQ = 606 * MiB_, WS_HID = 607 * MiB_, WS_CTL = 700 * MiB_, WS_END = 701 * MiB_;
constexpr size_t CTL_ZERO_BYTES = 16384;
constexpr size_t SM_STRIDE = 256 * 1024;
enum SmallBuf { SM_QS = 0, SM_XBS, SM_GGS, SM_SAS, SM_SBS, SM_OGS, SM_STS, SM_ATTS, SM_HBS, SM_TMPS, SM_MRGS, SM_X1S, SM_A2S, SM_SSQS, SM_HIDS, SM_XCS, SM_XCF, SM_N };
static_assert((SM_N + 2) * SM_STRIDE <= 6 * MiB_, "sample buffers");
__device__ __forceinline__ float bf2f(unsigned short b) { return __uint_as_float((unsigned)b << 16); }
__device__ __forceinline__ float sigmoidf_(float x) { return __builtin_amdgcn_rcpf(1.0f + __builtin_amdgcn_exp2f(-x * LOG2E_)); }
typedef float f32x4_c __attribute__((ext_vector_type(4)));
__device__ __forceinline__ f32x4_c sigmoid4_(f32x4_c x) { const f32x4_c t = x * (-LOG2E_); f32x4_c e; e[0] = __builtin_amdgcn_exp2f(t[0]); e[1] = __builtin_amdgcn_exp2f(t[1]); e[2] = __builtin_amdgcn_exp2f(t[2]); e[3] = __builtin_amdgcn_exp2f(t[3]);
    const f32x4_c d = e + 1.0f; f32x4_c r; r[0] = __builtin_amdgcn_rcpf(d[0]); r[1] = __builtin_amdgcn_rcpf(d[1]); r[2] = __builtin_amdgcn_rcpf(d[2]); r[3] = __builtin_amdgcn_rcpf(d[3]); return r; }
__device__ __forceinline__ f32x4_c gelu4_(f32x4_c x) { const f32x4_c u = (x * x * 0.044715f + 1.0f) * x * 1.5957691216057308f; return x * sigmoid4_(u); }
__device__ __forceinline__ float gelu_tanh_(float x) { const float u = 1.5957691216057308f * (x + 0.044715f * x * x * x); return x * sigmoidf_(u); }

namespace pg8 {
#define PG8_LAS __attribute__((address_space(3)))
typedef unsigned short bf16_t;
typedef short bf16x8 __attribute__((ext_vector_type(8)));
typedef float f32x4 __attribute__((ext_vector_type(4)));
typedef unsigned u32x4 __attribute__((ext_vector_type(4)));
constexpr int BM = 256, BK = 64, HALF = 128, HTB = HALF * BK * 2  , STAGE_BYTES = 8 * HTB, NXCD = 8, WGM = 8;

__host__ __device__ __forceinline__ int lds_byte(int r, int c) { const int st = (r >> 4) * 2 + (c >> 5), rr = r & 15, cc = c & 31, ob = rr * 64 + cc * 2; return st * 1024 + (ob ^ (((ob >> 9) & 1) << 5)); }
__host__ __device__ __forceinline__ void stage_rc(int b, int& R, int& C) { const int st = b / 1024, sb = b % 1024, swz = sb ^ (((sb >> 9) & 1) << 5); R = (st >> 1) * 16 + swz / 64; C = (st & 1) * 32 + (swz % 64) / 2; }
__host__ __device__ __forceinline__ int perm32(int rho) { const int n = rho >> 4, i = rho & 15; return 8 * (i >> 2) + 4 * n + (i & 3); }

struct Unit { int pm, pn; };
struct Gemm { const bf16_t* A; const bf16_t* Bt; int M, N, K, ld; };

struct StaticOrder {
    int nM, nN, nwg, G, c;
    __host__ __device__ void init(int M, int N, int G_, int c_) { nM = M / BM; nN = N / BM; nwg = nM * nN; G = G_; c = c_; }
    __host__ __device__ bool next(int i, Unit& u) const {
        const long L = (long)i * G + c; if (L >= nwg) return false;
        int wgid = (int)L; { const int q = nwg / NXCD, r = nwg % NXCD, xcd = wgid % NXCD, off = wgid / NXCD; wgid = (xcd < r ? xcd * (q + 1) : r * (q + 1) + (xcd - r) * q) + off; }
        const int nig = WGM * nN, gid = wgid / nig, fm = gid * WGM, gsz = (nM - fm) < WGM ? (nM - fm) : WGM;
        u.pm = fm + ((wgid % nig) % gsz); u.pn = (wgid % nig) / gsz; return true;
    }
    __device__ __forceinline__ void a_ready(const Unit&) const {}
    __device__ __forceinline__ void done(const Unit&) const {}
};

typedef float f32x2_cv __attribute__((ext_vector_type(2))); typedef __bf16 bf16x2_cv __attribute__((ext_vector_type(2)));
__device__ __forceinline__ unsigned cvt_pk_bf16(float lo, float hi) { f32x2_cv v = {lo, hi}; bf16x2_cv b = __builtin_convertvector(v, bf16x2_cv); return __builtin_bit_cast(unsigned, b); }
typedef float f32x2 __attribute__((ext_vector_type(2)));
__device__ __forceinline__ u32x4 pack8(const f32x4 a, const f32x4 b) { u32x4 w; w.x = cvt_pk_bf16(a[0], a[1]); w.y = cvt_pk_bf16(a[2], a[3]); w.z = cvt_pk_bf16(b[0], b[1]); w.w = cvt_pk_bf16(b[2], b[3]); return w; }
__device__ __forceinline__ void unpack8(const u32x4 w, f32x4& a, f32x4& b) {
    a[0] = __uint_as_float(w.x << 16); a[1] = __uint_as_float(w.x & 0xffff0000u); a[2] = __uint_as_float(w.y << 16); a[3] = __uint_as_float(w.y & 0xffff0000u);
    b[0] = __uint_as_float(w.z << 16); b[1] = __uint_as_float(w.z & 0xffff0000u); b[2] = __uint_as_float(w.w << 16); b[3] = __uint_as_float(w.w & 0xffff0000u); }

struct EpiIn {
    static constexpr bool PERM = true, AFTER_DRAIN = false;
    bf16_t *Q, *K, *V, *XB, *GG, *SA, *SB; float* out; const float *qg, *kg, *bgate;
    __device__ __forceinline__ void operator()(const f32x4 (&acc)[2][2][4][2], const Unit& u, int wr, int wc, int fr, int fq) const {
        const int pn = u.pn, row0 = u.pm * BM + wr * 64 + fr;
        const int cin = 64 * wc + 8 * fq;
        if (pn < 12) {
            const bool isq = pn < 6; const float* gv = isq ? qg : kg; const float sc = isq ? QSCALE_ : 1.0f;
            f32x4 gw[2][2];
#pragma unroll
            for (int bj = 0; bj < 2; ++bj)
#pragma unroll
                for (int n = 0; n < 2; ++n) gw[bj][n] = *(const f32x4*)(gv + 32 * bj + 8 * fq + 4 * n) * sc;
            bf16_t* dst = isq ? Q : K; const int cb = (isq ? pn : pn - 6) * 256 + cin;
            const int g = (pn - 6) >> 1, keep = 128 << (2 * (g < 0 ? 0 : g)), start = S_ - keep;
            const size_t obase = g <= 0 ? O_KVP0 : (g == 1 ? O_KVP1 : O_KVP2);
#pragma unroll
            for (int ai = 0; ai < 2; ++ai)
#pragma unroll
                for (int m = 0; m < 4; ++m) {
                    const int row = row0 + ai * HALF + m * 16;
                    float ss = 0.f;
#pragma unroll
                    for (int bj = 0; bj < 2; ++bj)
#pragma unroll
                        for (int n = 0; n < 2; ++n) { const f32x4 x = acc[ai][bj][m][n]; ss += (x[0] * x[0] + x[1] * x[1]) + (x[2] * x[2] + x[3] * x[3]); }
                    ss += __shfl_xor(ss, 16); ss += __shfl_xor(ss, 32);
                    const float rstd = __builtin_amdgcn_rsqf(ss * (1.0f / 64.0f) + RMS_EPS_);
#pragma unroll
                    for (int bj = 0; bj < 2; ++bj) {
                        const f32x4 v0 = acc[ai][bj][m][0] * rstd * gw[bj][0], v1 = acc[ai][bj][m][1] * rstd * gw[bj][1];
                        const int c = cb + 32 * bj;
                        *(u32x4*)(dst + (size_t)row * QKV_ + c) = pack8(v0, v1);
                        if (!isq && row >= start) { float* o = out + obase + (size_t)(row - start) * 1024 + (c & 511); *(f32x4*)o = v0; *(f32x4*)(o + 4) = v1; }
                    }
                }
        } else if (pn < 18) {
            const int cb = (pn - 12) * 256 + cin; const int g = (pn - 12) >> 1, keep = 128 << (2 * g), start = S_ - keep;
            const size_t obase = g == 0 ? O_KVP0 : (g == 1 ? O_KVP1 : O_KVP2);
#pragma unroll
            for (int ai = 0; ai < 2; ++ai)
#pragma unroll
                for (int m = 0; m < 4; ++m) {
                    const int row = row0 + ai * HALF + m * 16;
#pragma unroll
                    for (int bj = 0; bj < 2; ++bj) {
                        const f32x4 v0 = acc[ai][bj][m][0], v1 = acc[ai][bj][m][1]; const int c = cb + 32 * bj;
                        *(u32x4*)(V + (size_t)row * QKV_ + c) = pack8(v0, v1);
                        if (row >= start) { float* o = out + obase + (size_t)(row - start) * 1024 + 512 + (c & 511); *(f32x4*)o = v0; *(f32x4*)(o + 4) = v1; }
                    }
                }
        } else if (pn < 28) {
            const bool isx = pn < 23; bf16_t* dst = isx ? XB : GG; const int cb = (isx ? pn - 18 : pn - 23) * 256 + cin;
#pragma unroll
            for (int ai = 0; ai < 2; ++ai)
#pragma unroll
                for (int m = 0; m < 4; ++m) {
                    const int row = row0 + ai * HALF + m * 16;
#pragma unroll
                    for (int bj = 0; bj < 2; ++bj) {
                        f32x4 v0 = acc[ai][bj][m][0], v1 = acc[ai][bj][m][1]; const int c = cb + 32 * bj;
                        if (!isx) { v0 = gelu4_(v0); v1 = gelu4_(v1); }
                        *(u32x4*)(dst + (size_t)row * DR_ + c) = pack8(v0, v1);
                        if (isx && row >= S_ - 3) { float* o = out + O_CONVP + (size_t)(row - (S_ - 3)) * DR_ + c; *(f32x4*)o = v0; *(f32x4*)(o + 4) = v1; }
                    }
                }
        } else {
            const int c0 = (pn - 28) * HALF + wc * 32 + 8 * fq;
            f32x4 ba[2], bb[2];
#pragma unroll
            for (int n = 0; n < 2; ++n) { ba[n] = *(const f32x4*)(bgate + c0 + 4 * n); bb[n] = *(const f32x4*)(bgate + DM_ + c0 + 4 * n); }
#pragma unroll
            for (int ai = 0; ai < 2; ++ai)
#pragma unroll
                for (int m = 0; m < 4; ++m) {
                    const int row = row0 + ai * HALF + m * 16;
                    const f32x4 sa0 = sigmoid4_(acc[ai][0][m][0] + ba[0]), sa1 = sigmoid4_(acc[ai][0][m][1] + ba[1]);
                    const f32x4 sb0 = sigmoid4_(acc[ai][1][m][0] + bb[0]), sb1 = sigmoid4_(acc[ai][1][m][1] + bb[1]);
                    f32x4 r0, r1;
#pragma unroll
                    for (int e = 0; e < 4; ++e) { r0[e] = sa0[e] * __builtin_amdgcn_rcpf(fmaxf(sb0[e], 1e-18f)); r1[e] = sa1[e] * __builtin_amdgcn_rcpf(fmaxf(sb1[e], 1e-18f)); }
                    *(u32x4*)(SA + (size_t)row * DM_ + c0) = pack8(r0, r1);
                    *(u32x4*)(SB + (size_t)row * DM_ + c0) = pack8(sb0, sb1);
                }
        }
    }
};
struct EpiMrg {
    static constexpr bool PERM = true, AFTER_DRAIN = false;
    const bf16_t* R; const bf16_t* S; bf16_t* MRG;
    __device__ __forceinline__ void mid(f32x4 (&acc)[2][2][4][2], const Unit& u, int wr, int wc, int fr, int fq) const {
        const __amdgpu_buffer_rsrc_t rs = __builtin_amdgcn_make_buffer_rsrc((void*)R, 0, S_ * DM_ * 2, 0x00020000);
        const unsigned voff = (unsigned)(((u.pm * BM + wr * 64 + fr) * DM_ + u.pn * BM + wc * 32 + 8 * fq) * 2);
#pragma unroll
        for (int ai = 0; ai < 2; ++ai) {
            u32x4 rv[4][2];
#pragma unroll
            for (int m = 0; m < 4; ++m)
#pragma unroll
                for (int bj = 0; bj < 2; ++bj) rv[m][bj] = __builtin_amdgcn_raw_buffer_load_b128(rs, voff, (unsigned)(((ai * HALF + m * 16) * DM_ + bj * HALF) * 2), 0);
#pragma unroll
            for (int m = 0; m < 4; ++m)
#pragma unroll
                for (int bj = 0; bj < 2; ++bj) { f32x4 r0, r1; unpack8(rv[m][bj], r0, r1); acc[ai][bj][m][0] *= r0; acc[ai][bj][m][1] *= r1; }
            asm volatile("" ::: "memory");
        }
    }
    __device__ __forceinline__ void operator()(const f32x4 (&acc)[2][2][4][2], const Unit& u, int wr, int wc, int fr, int fq) const {
        const int row0 = u.pm * BM + wr * 64 + fr, col0 = u.pn * BM + wc * 32 + 8 * fq;
#pragma unroll
        for (int ai = 0; ai < 2; ++ai)
#pragma unroll
            for (int m = 0; m < 4; ++m)
#pragma unroll
                for (int bj = 0; bj < 2; ++bj) {
                    const size_t off = (size_t)(row0 + ai * HALF + m * 16) * DM_ + col0 + bj * HALF;
                    f32x4 s0, s1; unpack8(*(const u32x4*)(S + off), s0, s1);
                    *(u32x4*)(MRG + off) = pack8(acc[ai][bj][m][0] * s0, acc[ai][bj][m][1] * s1);
                }
    }
};
struct EpiWout {
    static constexpr bool PERM = true, AFTER_DRAIN = false;
    const float* X; float* Y; bf16_t* A2; float* SSQ; const float* g2;
    __device__ __forceinline__ void operator()(const f32x4 (&acc)[2][2][4][2], const Unit& u, int wr, int wc, int fr, int fq) const {
        const int row0 = u.pm * BM + wr * 64 + fr, col0 = u.pn * BM + wc * 32 + 8 * fq;
        f32x4 gw[2][2];
#pragma unroll
        for (int bj = 0; bj < 2; ++bj)
#pragma unroll
            for (int n = 0; n < 2; ++n) gw[bj][n] = *(const f32x4*)(g2 + col0 + bj * HALF + 4 * n);
#pragma unroll
        for (int ai = 0; ai < 2; ++ai)
#pragma unroll
            for (int m = 0; m < 4; ++m) {
                const int row = row0 + ai * HALF + m * 16; float ss = 0.f;
#pragma unroll
                for (int bj = 0; bj < 2; ++bj) {
                    const size_t off = (size_t)row * DM_ + col0 + bj * HALF;
                    const f32x4 x0 = *(const f32x4*)(X + off) + acc[ai][bj][m][0], x1 = *(const f32x4*)(X + off + 4) + acc[ai][bj][m][1];
                    *(f32x4*)(Y + off) = x0; *(f32x4*)(Y + off + 4) = x1;
                    ss += (x0[0] * x0[0] + x0[1] * x0[1]) + (x0[2] * x0[2] + x0[3] * x0[3]) + (x1[0] * x1[0] + x1[1] * x1[1]) + (x1[2] * x1[2] + x1[3] * x1[3]);
                    *(u32x4*)(A2 + off) = pack8(x0 * gw[bj][0], x1 * gw[bj][1]);
                }
                ss += __shfl_xor(ss, 16); ss += __shfl_xor(ss, 32);
                if (fq == 0) SSQ[(size_t)row * 16 + u.pn * 4 + wc] = ss;
            }
    }
};
struct EpiFfn1 {
    static constexpr bool PERM = true, AFTER_DRAIN = false;
    const float* SSQ; bf16_t* HID;
    __device__ __forceinline__ void operator()(const f32x4 (&acc)[2][2][4][2], const Unit& u, int wr, int wc, int fr, int fq) const {
        const int row0 = u.pm * BM + wr * 64 + fr, col0 = u.pn * HALF + wc * 32 + 8 * fq;
#pragma unroll
        for (int ai = 0; ai < 2; ++ai)
#pragma unroll
            for (int m = 0; m < 4; ++m) {
                const int row = row0 + ai * HALF + m * 16;
                const f32x4* sp = (const f32x4*)(SSQ + (size_t)row * 16);
                const f32x4 p0 = sp[0], p1 = sp[1], p2 = sp[2], p3 = sp[3];
                const float ssum = ((p0[0] + p0[1]) + (p0[2] + p0[3])) + ((p1[0] + p1[1]) + (p1[2] + p1[3])) + ((p2[0] + p2[1]) + (p2[2] + p2[3])) + ((p3[0] + p3[1]) + (p3[2] + p3[3]));
                const float rstd = __builtin_amdgcn_rsqf(ssum * (1.0f / 1024.0f) + RMS_EPS_);
                const f32x4 g0 = acc[ai][0][m][0] * rstd, u0 = acc[ai][1][m][0] * rstd, g1 = acc[ai][0][m][1] * rstd, u1 = acc[ai][1][m][1] * rstd;
                const f32x4 h0 = g0 * sigmoid4_(g0) * u0, h1 = g1 * sigmoid4_(g1) * u1;
                *(u32x4*)(HID + (size_t)row * LDH_ + col0) = pack8(h0, h1);
            }
    }
};
struct EpiOut {
    static constexpr bool PERM = true, AFTER_DRAIN = false;
    float* Y;
    __device__ __forceinline__ void operator()(const f32x4 (&acc)[2][2][4][2], const Unit& u, int wr, int wc, int fr, int fq) const {
        const int row0 = u.pm * BM + wr * 64 + fr, col0 = u.pn * BM + wc * 32 + 8 * fq;
#pragma unroll
        for (int ai = 0; ai < 2; ++ai)
#pragma unroll
            for (int m = 0; m < 4; ++m)
#pragma unroll
                for (int bj = 0; bj < 2; ++bj) {
                    float* p = Y + (size_t)(row0 + ai * HALF + m * 16) * DM_ + col0 + bj * HALF;
                    const f32x4 a = *(const f32x4*)p + acc[ai][bj][m][0], b = *(const f32x4*)(p + 4) + acc[ai][bj][m][1];
                    *(f32x4*)p = a; *(f32x4*)(p + 4) = b;
                }
    }
};

template <class Epi, class Sched, bool ALIGN_EPI = false, bool SP2 = false, int MID_T = 0>
__device__ __forceinline__ void gemm_phase(PG8_LAS unsigned char* lds, const Gemm g, const Sched& S, const Epi& E) {
    const int tid = threadIdx.x, wid = __builtin_amdgcn_readfirstlane(tid >> 6), lane = tid & 63, wr = wid >> 2, wc = wid & 3, fr = lane & 15, fq = lane >> 4;
    const int K = g.K, nt = K / BK;
    unsigned voffA[2], voffB[2];
#pragma unroll
    for (int i = 0; i < 2; ++i) { int R, C; stage_rc(tid * 16 + i * 8192, R, C); const int Rb = Epi::PERM ? ((R & ~31) + perm32(R & 31)) : R;
        voffA[i] = (unsigned)(R * g.ld + C) * 2u; voffB[i] = (unsigned)(Rb * g.ld + C) * 2u; }
    const size_t kstep = (size_t)(BK * 2);
    const size_t hstep = (size_t)HALF * g.ld * 2;
    const size_t tstep = 2 * hstep;
    const unsigned ldsw = (unsigned)wid * 1024u;
    const int aoff = lds_byte(wr * 64 + fr, fq * 8), boff = lds_byte(wc * 32 + fr, fq * 8);
#define PG8_SA(b, h) (((b) * 2 + (h)) * HTB)
#define PG8_SB(b, h) ((4 + (b) * 2 + (h)) * HTB)
#define PG8_STAGE(bufoff, gbase, voff) do { _Pragma("unroll") for (int _i = 0; _i < 2; ++_i) \
        __builtin_amdgcn_global_load_lds((const unsigned*)((const char*)(gbase) + (voff)[_i]), (PG8_LAS unsigned*)(lds + (bufoff) + ldsw + _i * 8192), 16, 0, 0); } while (0)
#define PG8_LDA(dst, b, h) do { _Pragma("unroll") for (int m = 0; m < 4; ++m) _Pragma("unroll") for (int k = 0; k < 2; ++k) dst[m][k] = *(const PG8_LAS bf16x8*)(lds + PG8_SA(b, h) + aoff + m * 2048 + k * 1024); } while (0)
#define PG8_LDB(dst, b, h) do { _Pragma("unroll") for (int n = 0; n < 2; ++n) _Pragma("unroll") for (int k = 0; k < 2; ++k) dst[n][k] = *(const PG8_LAS bf16x8*)(lds + PG8_SB(b, h) + boff + n * 2048 + k * 1024); } while (0)
#define PG8_MMA(ai, bj, At, Bt) do { __builtin_amdgcn_s_setprio(1); _Pragma("unroll") for (int m = 0; m < 4; ++m) _Pragma("unroll") for (int n = 0; n < 2; ++n) _Pragma("unroll") for (int k = 0; k < 2; ++k) \
        acc[ai][bj][m][n] = __builtin_amdgcn_mfma_f32_16x16x32_bf16(Bt[n][k], At[m][k], acc[ai][bj][m][n], 0, 0, 0); __builtin_amdgcn_s_setprio(0); } while (0)
#define PG8_WAIT_V(n) asm volatile("s_waitcnt vmcnt(" #n ")" ::: "memory")
#define PG8_WAIT_L(n) asm volatile("s_waitcnt lgkmcnt(" #n ")" ::: "memory")
#define PG8_BAR __builtin_amdgcn_s_barrier()
#define PG8_SCHED __builtin_amdgcn_sched_barrier(0)
    Unit cur, nxt; int ui = 0;
    if (!S.next(0, cur)) return;
    f32x4 acc[2][2][4][2];
#pragma unroll
    for (int a = 0; a < 2; ++a)
#pragma unroll
        for (int b = 0; b < 2; ++b)
#pragma unroll
            for (int m = 0; m < 4; ++m)
#pragma unroll
                for (int n = 0; n < 2; ++n) acc[a][b][m][n] = (f32x4){0.f, 0.f, 0.f, 0.f};
    bf16x8 At[4][2], B0[2][2], B1[2][2];
    const char* cA = (const char*)g.A + (size_t)cur.pm * tstep; const char* cB = (const char*)g.Bt + (size_t)cur.pn * tstep;
    S.a_ready(cur);
    if constexpr (SP2) {
        PG8_STAGE(PG8_SB(0, 0), cB, voffB); PG8_STAGE(PG8_SB(0, 1), cB + hstep, voffB); PG8_STAGE(PG8_SA(0, 0), cA, voffA); PG8_STAGE(PG8_SA(0, 1), cA + hstep, voffA);
        if (wr == 1) PG8_BAR;
        PG8_WAIT_V(2); PG8_BAR;
        PG8_STAGE(PG8_SB(1, 0), cB + kstep, voffB); PG8_STAGE(PG8_SA(1, 0), cA + kstep, voffA); PG8_STAGE(PG8_SB(1, 1), cB + hstep + kstep, voffB);
        PG8_WAIT_V(6); PG8_BAR;
    } else {
        PG8_STAGE(PG8_SB(0, 0), cB, voffB); PG8_STAGE(PG8_SA(0, 0), cA, voffA); PG8_STAGE(PG8_SB(0, 1), cB + hstep, voffB); PG8_STAGE(PG8_SA(0, 1), cA + hstep, voffA);
        if (wr == 1) PG8_BAR;
        PG8_WAIT_V(4); PG8_BAR;
        PG8_STAGE(PG8_SB(1, 0), cB + kstep, voffB); PG8_STAGE(PG8_SA(1, 0), cA + kstep, voffA); PG8_STAGE(PG8_SB(1, 1), cB + hstep + kstep, voffB);
        PG8_WAIT_V(6); PG8_BAR;
    }
    for (;;) {
        const bool has_next = S.next(ui + 1, nxt);
        const char* nA = has_next ? (const char*)g.A + (size_t)nxt.pm * tstep : cA; const char* nB = has_next ? (const char*)g.Bt + (size_t)nxt.pn * tstep : cB;
        for (int t = 0; t < nt; t += 2) {
            if constexpr (MID_T > 0) { if (t == MID_T) E.mid(acc, cur, wr, wc, fr, fq); }
            const bool last = (t == nt - 2);
            const char* a1 = cA + (size_t)(t + 1) * kstep;
            const char* a2 = last ? nA : cA + (size_t)(t + 2) * kstep; const char* b2 = last ? nB : cB + (size_t)(t + 2) * kstep;
            const char* a3 = a2 + kstep; const char* b3 = b2 + kstep;
            if (last && has_next) S.a_ready(nxt);
            if constexpr (SP2) {
            PG8_LDB(B0, 0, 0); PG8_LDB(B1, 0, 1); PG8_SCHED; PG8_LDA(At, 0, 0); PG8_STAGE(PG8_SA(1, 1), a1 + hstep, voffA);
            PG8_WAIT_V(8); PG8_WAIT_L(0); PG8_BAR; PG8_MMA(0, 0, At, B0); PG8_MMA(0, 1, At, B1); PG8_BAR; PG8_SCHED;
            PG8_LDA(At, 0, 1); PG8_STAGE(PG8_SB(0, 0), b2, voffB); PG8_STAGE(PG8_SB(0, 1), b2 + hstep, voffB); PG8_STAGE(PG8_SA(0, 0), a2, voffA);
            PG8_WAIT_V(8); PG8_WAIT_L(0); PG8_BAR; PG8_MMA(1, 0, At, B0); PG8_MMA(1, 1, At, B1); PG8_BAR; PG8_SCHED;
            PG8_LDB(B0, 1, 0); PG8_LDB(B1, 1, 1); PG8_SCHED; PG8_LDA(At, 1, 0); PG8_STAGE(PG8_SA(0, 1), a2 + hstep, voffA);
            PG8_WAIT_V(8); PG8_WAIT_L(0); PG8_BAR; PG8_MMA(0, 0, At, B0); PG8_MMA(0, 1, At, B1); PG8_BAR; PG8_SCHED;
            PG8_LDA(At, 1, 1); PG8_STAGE(PG8_SB(1, 0), b3, voffB); PG8_STAGE(PG8_SB(1, 1), b3 + hstep, voffB); PG8_STAGE(PG8_SA(1, 0), a3, voffA);
            PG8_WAIT_V(8); PG8_WAIT_L(0); PG8_BAR; PG8_MMA(1, 0, At, B0); PG8_MMA(1, 1, At, B1); PG8_BAR; PG8_SCHED;
            } else {
            PG8_LDB(B0, 0, 0); PG8_SCHED; PG8_LDA(At, 0, 0); PG8_STAGE(PG8_SA(1, 1), a1 + hstep, voffA);
            PG8_WAIT_L(8); PG8_BAR; PG8_WAIT_L(0); PG8_MMA(0, 0, At, B0); PG8_BAR; PG8_SCHED;
            PG8_LDB(B1, 0, 1); PG8_STAGE(PG8_SB(0, 0), b2, voffB);
            PG8_BAR; PG8_WAIT_L(0); PG8_MMA(0, 1, At, B1); PG8_BAR;
            PG8_LDA(At, 0, 1); PG8_STAGE(PG8_SA(0, 0), a2, voffA);
            PG8_BAR; PG8_WAIT_L(0); PG8_MMA(1, 0, At, B0); PG8_BAR; PG8_SCHED;
            PG8_STAGE(PG8_SB(0, 1), b2 + hstep, voffB);
            PG8_WAIT_V(6); PG8_BAR; PG8_MMA(1, 1, At, B1); PG8_BAR;
            PG8_LDB(B0, 1, 0); PG8_SCHED; PG8_LDA(At, 1, 0); PG8_STAGE(PG8_SA(0, 1), a2 + hstep, voffA);
            PG8_WAIT_L(8); PG8_BAR; PG8_WAIT_L(0); PG8_MMA(0, 0, At, B0); PG8_BAR; PG8_SCHED;
            PG8_LDB(B1, 1, 1); PG8_STAGE(PG8_SB(1, 0), b3, voffB);
            PG8_BAR; PG8_WAIT_L(0); PG8_MMA(0, 1, At, B1); PG8_BAR;
            PG8_LDA(At, 1, 1); PG8_STAGE(PG8_SA(1, 0), a3, voffA);
            PG8_BAR; PG8_WAIT_L(0); PG8_MMA(1, 0, At, B0); PG8_BAR; PG8_SCHED;
            PG8_STAGE(PG8_SB(1, 1), b3 + hstep, voffB);
            PG8_WAIT_V(6); PG8_BAR; PG8_MMA(1, 1, At, B1); PG8_BAR;
            }
        }
        if constexpr (ALIGN_EPI) { if (wr == 0) PG8_BAR; }
        if constexpr (!Epi::AFTER_DRAIN) { E(acc, cur, wr, wc, fr, fq); S.done(cur); }
        if (!has_next) break;
#pragma unroll
        for (int a = 0; a < 2; ++a)
#pragma unroll
            for (int b = 0; b < 2; ++b)
#pragma unroll
                for (int m = 0; m < 4; ++m)
#pragma unroll
                    for (int n = 0; n < 2; ++n) acc[a][b][m][n] = (f32x4){0.f, 0.f, 0.f, 0.f};
        cur = nxt; cA = nA; cB = nB; ++ui;
        if constexpr (ALIGN_EPI) { if (wr == 1) PG8_BAR; }
    }
    PG8_WAIT_V(0);
    if constexpr (!ALIGN_EPI) { if (wr == 0) PG8_BAR; }
    PG8_BAR;
    if constexpr (Epi::AFTER_DRAIN) { E.fused(acc, cur, wr, wc, fr, fq, lds, wid, lane); S.done(cur); }
#undef PG8_SA
#undef PG8_SB
#undef PG8_STAGE
#undef PG8_LDA
#undef PG8_LDB
#undef PG8_MMA
#undef PG8_WAIT_V
#undef PG8_WAIT_L
#undef PG8_BAR
#undef PG8_SCHED
}
}

#define LAS __attribute__((address_space(3)))
typedef unsigned short bf16_t;
typedef short bf16x8 __attribute__((ext_vector_type(8)));
typedef float f32x4 __attribute__((ext_vector_type(4)));
typedef float f32x2 __attribute__((ext_vector_type(2)));
typedef float f32x16 __attribute__((ext_vector_type(16)));
typedef unsigned u32x4 __attribute__((ext_vector_type(4)));
typedef unsigned u32x2 __attribute__((ext_vector_type(2)));
constexpr int NWAVES = 8, NTHREADS = 512;
constexpr int RING_BYTES = 131072, MISC_OFF = RING_BYTES, LDS_BYTES = 147456;
using pg8::cvt_pk_bf16; using pg8::pack8; using pg8::unpack8;

struct Args {
    const float *x, *xs, *c128, *c512, *c2048, *sconv, *sh, *n1g, *w_in, *bgate, *qg, *kg, *convw, *convb, *w_rg, *b_rg, *w_ig, *b_ig, *lam, *w_oa, *w_ob, *w_out, *n2g, *w_f1, *w_f2;
    float* out; unsigned char* ws; int ph_lo, ph_hi;
};

__device__ __forceinline__ float wave_sum(float v) {
#pragma unroll
    for (int o = 1; o < 64; o <<= 1) v += __shfl_xor(v, o);
    return v;
}

#define RLX_AGENT __ATOMIC_RELAXED, __HIP_MEMORY_SCOPE_AGENT
#define XB_TMO      128
#define XB_XCNT(j)  (256  + 64 * (j))
#define XB_XSUB(j)  (1280 + 64 * (j))
#define XB_XGEN(j)  (2304 + 64 * (j))
#define XB_TOP      3328
#define XB_TOPGEN   3392
#define XCD_BAR_WORDS 3456
#define XB_SPIN_CAP (1u << 18)

__device__ __forceinline__ unsigned xb_ld(unsigned* p)              { return __hip_atomic_load(p, __ATOMIC_RELAXED, __HIP_MEMORY_SCOPE_AGENT); }
__device__ __forceinline__ unsigned xb_add(unsigned* p, unsigned v) { return __hip_atomic_fetch_add(p, v, __ATOMIC_RELAXED, __HIP_MEMORY_SCOPE_AGENT); }
__device__ __forceinline__ unsigned xb_xcc_id() { return (unsigned)__builtin_amdgcn_s_getreg((3 << 11) | 20) & 0xFu; }
#define XB_SPIN(cond, bar) do { unsigned _sp = 0; while (cond) { __builtin_amdgcn_s_sleep(1); \
    if ((++_sp & 255u) == 0u) { if (xb_ld(&(bar)[XB_TMO])) break; if (_sp > XB_SPIN_CAP) { atomicAdd(&(bar)[XB_TMO], 1u); break; } } } } while (0)

struct XcdBarrier {
    unsigned* bar; unsigned x;
    volatile LAS unsigned* st;
};

__device__ __forceinline__ XcdBarrier xcd_barrier_post(unsigned* bar, volatile LAS unsigned* st) {
    XcdBarrier b; b.bar = bar; b.x = xb_xcc_id(); b.st = st;
    if (threadIdx.x == 0) (void)xb_add(&bar[XB_XCNT(b.x)], 1u);
    return b;
}
__device__ __forceinline__ void xcd_barrier_complete(unsigned* bar, unsigned x, unsigned& nloc, unsigned& nx) {
    const unsigned G = gridDim.x * gridDim.y * gridDim.z;
    unsigned sum, cnt, mine, sp = 0u;
    for (;;) {
        sum = 0u; cnt = 0u; mine = 0u;
#pragma unroll
        for (unsigned j = 0; j < 16; ++j) { const unsigned c = xb_ld(&bar[XB_XCNT(j)]); sum += c; cnt += (c > 0u) ? 1u : 0u; mine = (j == x) ? c : mine; }
        if (sum == G) break;
        __builtin_amdgcn_s_sleep(1);
        if ((++sp & 255u) == 0u) { if (xb_ld(&bar[XB_TMO])) break; if (sp > XB_SPIN_CAP) { atomicAdd(&bar[XB_TMO], 1u); break; } }
    }
    nloc = mine > 0u ? mine : 1u; nx = cnt > 0u ? cnt : 1u;
}

__device__ __forceinline__ void xcd_barrier(const XcdBarrier& b) {
    asm volatile("s_waitcnt vmcnt(0)" ::: "memory");
    __syncthreads();
    if (threadIdx.x == 0) {
        unsigned* bar = b.bar;
        __builtin_amdgcn_s_waitcnt(0);
        unsigned nloc = b.st[0], nx = b.st[1];
        if (nloc == 0u) { xcd_barrier_complete(bar, b.x, nloc, nx); b.st[0] = nloc; b.st[1] = nx; }
        const unsigned old = xb_add(&bar[XB_XSUB(b.x)], 1u);
        const unsigned gen = old / nloc;
        if (old + 1u == (gen + 1u) * nloc) {
            __builtin_amdgcn_fence(__ATOMIC_RELEASE, "agent");
            asm volatile("s_waitcnt vmcnt(0)" ::: "memory");
            const unsigned og = xb_add(&bar[XB_TOP], 1u);
            const unsigned tg = og / nx;
            if (og + 1u == (tg + 1u) * nx) xb_add(&bar[XB_TOPGEN], 1u);
            else XB_SPIN(xb_ld(&bar[XB_TOPGEN]) == tg, bar);
            __builtin_amdgcn_fence(__ATOMIC_ACQUIRE, "agent");
            xb_add(&bar[XB_XGEN(b.x)], 1u);
            asm volatile("s_waitcnt vmcnt(0)" ::: "memory");
        } else {
            XB_SPIN(xb_ld(&bar[XB_XGEN(b.x)]) == gen, bar);
            __builtin_amdgcn_fence(__ATOMIC_ACQUIRE, "agent");
            asm volatile("s_waitcnt vmcnt(0)" ::: "memory");
        }
    }
    __syncthreads();
}

__device__ __forceinline__ void tr_item(const float* W, int ldw, int k0, int n0, bf16_t* WT, int ldt, int dst_row0, LAS float* scr, int lane) {
    float wv[32];
#pragma unroll
    for (int i = 0; i < 32; ++i) wv[i] = W[(size_t)(k0 + 2 * i + (lane >> 5)) * ldw + n0 + (lane & 31)];
#pragma unroll
    for (int i = 0; i < 32; ++i) scr[(2 * i + (lane >> 5)) * 33 + (lane & 31)] = wv[i];
    asm volatile("s_waitcnt lgkmcnt(0)" ::: "memory");
    const int c = lane & 7;
#pragma unroll
    for (int j = 0; j < 4; ++j) { const int n = (lane >> 3) + 8 * j; const LAS float* s = scr + (8 * c) * 33 + n;
        u32x4 o; o.x = cvt_pk_bf16(s[0 * 33], s[1 * 33]); o.y = cvt_pk_bf16(s[2 * 33], s[3 * 33]); o.z = cvt_pk_bf16(s[4 * 33], s[5 * 33]); o.w = cvt_pk_bf16(s[6 * 33], s[7 * 33]);
        *(u32x4*)(WT + (size_t)(dst_row0 + n) * ldt + k0 + 8 * c) = o; }
    asm volatile("s_waitcnt lgkmcnt(0)" ::: "memory");
}
template <int PART>
__device__ __forceinline__ void p0_prologue(const Args& a, LAS unsigned char* lds, int blk, int G) {
    const int tid = threadIdx.x, lane = tid & 63, wid = tid >> 6;
    LAS float* scr = (LAS float*)(lds + wid * 16384);
    const int gw = blk * NWAVES + wid, NGW = G * NWAVES;
    unsigned char* ws = a.ws;
    constexpr int I_IN = 16 * 288, I_G = 160, I_OA = 8 * 32, I_OB = 20 * 32, I_OUT = 16 * 32, I_F1 = 16 * 176, I_F2 = 44 * 32;
    constexpr int NITEMS = I_IN + I_G + I_OA + I_OB + I_OUT + I_F1 + I_F2;
    for (int it = (PART == 0 ? gw : I_IN + I_G + gw); it < (PART == 0 ? I_IN + I_G : NITEMS); it += NGW) {
        int r = it;
        if (r < I_IN) { const int kb = r / 288, nb = r % 288, c = 32 * nb; int dst = (c & ~255) + 128 * ((c >> 5) & 1) + 32 * ((c >> 6) & 3);
            if (c >= 7168) { const int cc = c - 7168, bj = cc >> 10, c2 = cc & 1023; dst = 256 * (28 + (c2 >> 7)) + 128 * bj + (c2 & 127); }
            tr_item(a.w_in, INW_, 64 * kb, c, (bf16_t*)(ws + WS_WIN), DM_, dst, scr, lane); continue; } r -= I_IN;
        if (r < I_G) { const int mat = r >> 3, l = r & 7, n = mat >> 1, which = mat & 1, kb = l >> 2, nb = l & 3;
            tr_item((which ? a.w_ig : a.w_rg) + (size_t)n * 16384, 128, 64 * kb, 32 * nb, (bf16_t*)(ws + WS_WG), 128, n * 256 + which * 128 + 32 * nb, scr, lane); continue; } r -= I_G;
        if (r < I_OA) { const int kb = r / 32, nb = r % 32; tr_item(a.w_oa, DM_, 64 * kb, 32 * nb, (bf16_t*)(ws + WS_WOA), KCAT_, 32 * nb, scr, lane); continue; } r -= I_OA;
        if (r < I_OB) { const int kb = r / 32, nb = r % 32; tr_item(a.w_ob, DM_, 64 * kb, 32 * nb, (bf16_t*)(ws + WS_WOA) + 512, KCAT_, 32 * nb, scr, lane); continue; } r -= I_OB;
        if (r < I_OUT) { const int kb = r / 32, nb = r % 32; tr_item(a.w_out, DM_, 64 * kb, 32 * nb, (bf16_t*)(ws + WS_WOUT), DM_, 32 * nb, scr, lane); continue; } r -= I_OUT;
        if (r < I_F1) { const int kb = r / 176, nb = r % 176, c = 32 * nb, bj = c >= DFF_ ? 1 : 0, cc = c - bj * DFF_; const int dst = 256 * (cc >> 7) + 128 * bj + (cc & 127);
            tr_item(a.w_f1, 2 * DFF_, 64 * kb, c, (bf16_t*)(ws + WS_WFF1), DM_, dst, scr, lane); continue; } r -= I_F1;
        { const int kb = r / 32, nb = r % 32; tr_item(a.w_f2, DM_, 64 * kb, 32 * nb, (bf16_t*)(ws + WS_WFF2), LDH_, 32 * nb, scr, lane); }
    }
    if (PART != 0) return;
    bf16_t* HN = (bf16_t*)(ws + WS_HN);
    f32x4 gv[4];
#pragma unroll
    for (int j = 0; j < 4; ++j) gv[j] = ((const f32x4*)a.n1g)[64 * j + lane];
    for (int m0 = gw; m0 < S_ + NBS; m0 += 4 * NGW) {
        f32x4 v[4][4];
#pragma unroll
        for (int r = 0; r < 4; ++r) { const int m = m0 + r * NGW; const int mm = m < S_ + NBS ? m : m0;
            const float* xr = mm < S_ ? a.x + (size_t)mm * DM_ : a.xs + (size_t)(mm - S_) * DM_;
#pragma unroll
            for (int j = 0; j < 4; ++j) v[r][j] = ((const f32x4*)xr)[64 * j + lane]; }
#pragma unroll
        for (int r = 0; r < 4; ++r) { const int m = m0 + r * NGW; float s = 0.f;
#pragma unroll
            for (int j = 0; j < 4; ++j) s += (v[r][j][0] * v[r][j][0] + v[r][j][1] * v[r][j][1]) + (v[r][j][2] * v[r][j][2] + v[r][j][3] * v[r][j][3]);
            const float rstd = 1.0f / sqrtf(wave_sum(s) * (1.0f / DM_) + RMS_EPS_);
            if (m < S_ + NBS) { u32x2* o = (u32x2*)(HN + (size_t)m * DM_);
#pragma unroll
                for (int j = 0; j < 4; ++j) { const f32x4 y = v[r][j] * rstd * gv[j]; u32x2 w; w.x = cvt_pk_bf16(y[0], y[1]); w.y = cvt_pk_bf16(y[2], y[3]); o[64 * j + lane] = w; } } }
    }
}

template <int K, int UNR, class Epi>
__device__ __forceinline__ void small_gemm(LAS unsigned char* lds, const bf16_t* A, int lda, const bf16_t* Bt, int ldb, int ntiles, int G, int blk, const Epi& E) {
    const int tid = threadIdx.x, lane = tid & 63, wid = tid >> 6, r32 = lane & 31, h2 = lane >> 5;
    constexpr int kw = K >> 3, NST = kw / 16; static_assert(NST % UNR == 0, "small_gemm: UNR divides the k-steps per wave");
    LAS float* part = (LAS float*)lds; LAS float* red = (LAS float*)(lds + 65536);
    for (int t = G - 1 - blk; t < ntiles; t += G) {
        int b0, b1, acol; E.rows(t, b0, b1, acol);
        f32x16 c0, c1;
#pragma unroll
        for (int i = 0; i < 16; ++i) { c0[i] = 0.f; c1[i] = 0.f; }
        const bf16_t* ap = A + (size_t)r32 * lda + acol + wid * kw + 8 * h2;
        const bf16_t* bp0 = Bt + (size_t)(b0 + r32) * ldb + wid * kw + 8 * h2;
        const bf16_t* bp1 = Bt + (size_t)(b1 + r32) * ldb + wid * kw + 8 * h2;
#pragma unroll 1
        for (int kb = 0; kb < NST; kb += UNR) {
            bf16x8 av[UNR], x0[UNR], x1[UNR];
#pragma unroll
            for (int j = 0; j < UNR; ++j) { av[j] = *(const bf16x8*)(ap + 16 * (kb + j)); x0[j] = *(const bf16x8*)(bp0 + 16 * (kb + j)); x1[j] = *(const bf16x8*)(bp1 + 16 * (kb + j)); }
#pragma unroll
            for (int j = 0; j < UNR; ++j) { c0 = __builtin_amdgcn_mfma_f32_32x32x16_bf16(av[j], x0[j], c0, 0, 0, 0); c1 = __builtin_amdgcn_mfma_f32_32x32x16_bf16(av[j], x1[j], c1, 0, 0, 0); }
        }
#pragma unroll
        for (int r = 0; r < 16; ++r) { const int row = (r & 3) + 8 * (r >> 2) + 4 * h2; part[wid * 2048 + row * 64 + r32] = c0[r]; part[wid * 2048 + row * 64 + 32 + r32] = c1[r]; }
        __syncthreads();
        f32x4 s = *(const LAS f32x4*)(part + tid * 4);
#pragma unroll
        for (int w = 1; w < 8; ++w) s += *(const LAS f32x4*)(part + w * 2048 + tid * 4);
        *(LAS f32x4*)(red + tid * 4) = s;
        __syncthreads();
        E(t, red, tid);
        __syncthreads();
    }
}
struct SEpiIn {
    const Args* a; float *QS, *XBS, *GGS, *SAS, *SBS; bf16_t* XCS; float* XCF;
    __device__ __forceinline__ void rows(int t, int& b0, int& b1, int& acol) const { acol = 0; b0 = 256 * (t >> 2) + 32 * (t & 3); b1 = b0 + 128;
        if (t >= 112) { const int isb = t >= 128 ? 1 : 0, c = 64 * (t - 112 - 16 * isb); b0 = 256 * (28 + (c >> 7)) + 128 * isb + (c & 127); b1 = b0 + 32; } }
    __device__ __forceinline__ void operator()(int t, const LAS float* red, int tid) const {
        const int row = tid >> 4, c4 = (tid & 15) * 4; f32x4 v = *(const LAS f32x4*)(red + row * 64 + c4); float* out = a->out;
        if (t < 48) {
            float ss = (v[0] * v[0] + v[1] * v[1]) + (v[2] * v[2] + v[3] * v[3]);
            ss += __shfl_xor(ss, 1); ss += __shfl_xor(ss, 2); ss += __shfl_xor(ss, 4); ss += __shfl_xor(ss, 8);
            const float rstd = 1.0f / sqrtf(ss * (1.0f / 64.0f) + RMS_EPS_);
            if (t < 24) { const f32x4 g = *(const f32x4*)(a->qg + c4); *(f32x4*)(QS + row * QKV_ + 64 * t + c4) = v * rstd * g * QSCALE_; }
            else { const int hh = t - 24, g = hh >> 3, h = hh & 7; const f32x4 gk = *(const f32x4*)(a->kg + c4);
                const size_t ob = g == 0 ? O_KVS0 : (g == 1 ? O_KVS1 : O_KVS2); *(f32x4*)(out + ob + (size_t)row * 1024 + h * 64 + c4) = v * rstd * gk; }
        } else if (t < 72) { const int hh = t - 48, g = hh >> 3, h = hh & 7; const size_t ob = g == 0 ? O_KVS0 : (g == 1 ? O_KVS1 : O_KVS2);
            *(f32x4*)(out + ob + (size_t)row * 1024 + 512 + h * 64 + c4) = v;
        } else if (t < 92) { const int c = 64 * (t - 72) + c4; *(f32x4*)(XBS + row * DR_ + c) = v;
            float* cs = out + O_CONVS + (size_t)row * 3 * DR_ + c; const float* sc = a->sconv + (size_t)row * 3 * DR_ + c;
            const f32x4 s0 = *(const f32x4*)sc, s1 = *(const f32x4*)(sc + DR_), s2 = *(const f32x4*)(sc + 2 * DR_);
            *(f32x4*)cs = s1; *(f32x4*)(cs + DR_) = s2; *(f32x4*)(cs + 2 * DR_) = v;
            const float* cw = a->convw + c; const f32x4 xc = *(const f32x4*)(a->convb + c) + s0 * *(const f32x4*)cw + s1 * *(const f32x4*)(cw + DR_) + s2 * *(const f32x4*)(cw + 2 * DR_) + v * *(const f32x4*)(cw + 3 * DR_);
            *(f32x4*)(XCF + row * DR_ + c) = xc; u32x2 w; w.x = cvt_pk_bf16(xc[0], xc[1]); w.y = cvt_pk_bf16(xc[2], xc[3]); *(u32x2*)(XCS + row * DR_ + c) = w;
        } else if (t < 112) { const int c = 64 * (t - 92) + c4;
#pragma unroll
            for (int e = 0; e < 4; ++e) v[e] = gelu_tanh_(v[e]);
            *(f32x4*)(GGS + row * DR_ + c) = v;
        } else { const bool isa = t < 128; const int c = 64 * (isa ? t - 112 : t - 128) + c4; const f32x4 b = *(const f32x4*)(a->bgate + (isa ? 0 : DM_) + c);
#pragma unroll
            for (int e = 0; e < 4; ++e) v[e] = sigmoidf_(v[e] + b[e]);
            *(f32x4*)((isa ? SAS : SBS) + row * DM_ + c) = v; }
    }
};
struct SEpiYa { const float* SAS; float* TMPS;
    __device__ __forceinline__ void rows(int t, int& b0, int& b1, int& acol) const { acol = 0; b0 = 64 * t; b1 = b0 + 32; }
    __device__ __forceinline__ void operator()(int t, const LAS float* red, int tid) const {
        const int row = tid >> 4, c = 64 * t + (tid & 15) * 4; const f32x4 v = *(const LAS f32x4*)(red + tid * 4);
        *(f32x4*)(TMPS + row * DM_ + c) = v * *(const f32x4*)(SAS + row * DM_ + c); }
};
struct SEpiYb { const float* SBS; const float* TMPS; bf16_t* MRGS;
    __device__ __forceinline__ void rows(int t, int& b0, int& b1, int& acol) const { acol = 0; b0 = 64 * t; b1 = b0 + 32; }
    __device__ __forceinline__ void operator()(int t, const LAS float* red, int tid) const {
        const int row = tid >> 4, c = 64 * t + (tid & 15) * 4; const f32x4 v = *(const LAS f32x4*)(red + tid * 4);
        const f32x4 y = *(const f32x4*)(TMPS + row * DM_ + c) + v * *(const f32x4*)(SBS + row * DM_ + c);
        u32x2 w; w.x = cvt_pk_bf16(y[0], y[1]); w.y = cvt_pk_bf16(y[2], y[3]); *(u32x2*)(MRGS + row * DM_ + c) = w; }
};
struct SEpiWout { const float* xs; const float* g2; float* X1S; bf16_t* A2S; float* SSQS;
    __device__ __forceinline__ void rows(int t, int& b0, int& b1, int& acol) const { acol = 0; b0 = 64 * t; b1 = b0 + 32; }
    __device__ __forceinline__ void operator()(int t, const LAS float* red, int tid) const {
        const int row = tid >> 4, c = 64 * t + (tid & 15) * 4; const f32x4 v = *(const LAS f32x4*)(red + tid * 4);
        const f32x4 x1 = *(const f32x4*)(xs + row * DM_ + c) + v; *(f32x4*)(X1S + row * DM_ + c) = x1;
        const f32x4 y = x1 * *(const f32x4*)(g2 + c); u32x2 w; w.x = cvt_pk_bf16(y[0], y[1]); w.y = cvt_pk_bf16(y[2], y[3]); *(u32x2*)(A2S + row * DM_ + c) = w;
        float ss = (x1[0] * x1[0] + x1[1] * x1[1]) + (x1[2] * x1[2] + x1[3] * x1[3]);
        ss += __shfl_xor(ss, 1); ss += __shfl_xor(ss, 2); ss += __shfl_xor(ss, 4); ss += __shfl_xor(ss, 8);
        if ((tid & 15) == 0) SSQS[row * 16 + t] = ss; }
};
struct SEpiFfn1 { const float* SSQS; bf16_t* HIDS;
    __device__ __forceinline__ void rows(int t, int& b0, int& b1, int& acol) const { acol = 0; b0 = 256 * (t >> 2) + 32 * (t & 3); b1 = b0 + 128; }
    __device__ __forceinline__ void operator()(int t, const LAS float* red, int tid) const {
        const int row = tid >> 4, cp = (tid & 15) * 2;
        float ssum = 0.f;
#pragma unroll
        for (int i = 0; i < 16; ++i) ssum += SSQS[row * 16 + i];
        const float rstd = 1.0f / sqrtf(ssum * (1.0f / DM_) + RMS_EPS_);
        const float g0 = red[row * 64 + cp] * rstd, g1 = red[row * 64 + cp + 1] * rstd, u0 = red[row * 64 + 32 + cp] * rstd, u1 = red[row * 64 + 32 + cp + 1] * rstd;
        *(unsigned*)(HIDS + row * DFF_ + 128 * (t >> 2) + 32 * (t & 3) + cp) = cvt_pk_bf16(g0 * sigmoidf_(g0) * u0, g1 * sigmoidf_(g1) * u1); }
};
struct SEpiOut { const float* X1S; float* YS;
    __device__ __forceinline__ void rows(int t, int& b0, int& b1, int& acol) const { acol = 0; b0 = 64 * t; b1 = b0 + 32; }
    __device__ __forceinline__ void operator()(int t, const LAS float* red, int tid) const {
        const int row = tid >> 4, c = 64 * t + (tid & 15) * 4; const f32x4 v = *(const LAS f32x4*)(red + tid * 4);
        *(f32x4*)(YS + row * DM_ + c) = *(const f32x4*)(X1S + row * DM_ + c) + v; }
};

__device__ __forceinline__ void lru_ab(float racc, float iacc, float brg, float big, float c8, float xcv, float& av, float& bv) {
    const float rr = sigmoidf_(racc + brg), ii = sigmoidf_(iacc + big), la = c8 * rr;
    av = __builtin_amdgcn_exp2f(la * LOG2E_);
    const float x2 = 2.0f * la;
    const float ser = -(x2 * (1.0f + x2 * (0.5f + x2 * (0.16666667f + x2 * (0.041666668f + x2 * (0.0083333338f + x2 * 0.0013888889f))))));
    const float em = x2 > -0.25f ? ser : 1.0f - av * av;
    bv = __builtin_amdgcn_sqrtf(em) * ii * xcv;
}
struct SEpiRnn { const Args* a; const float* XCF; const float* GGS; bf16_t* HBS;
    __device__ __forceinline__ void rows(int t, int& b0, int& b1, int& acol) const { acol = 128 * (t >> 2); b0 = 256 * (t >> 2) + 32 * (t & 3); b1 = b0 + 128; }
    __device__ __forceinline__ void operator()(int t, const LAS float* red, int tid) const {
        const int row = tid >> 4, cp = (tid & 15) * 2;
#pragma unroll
        for (int e = 0; e < 2; ++e) { const int ch = 128 * (t >> 2) + 32 * (t & 3) + cp + e;
            const float c8 = -8.0f * log1pf(expf(-a->lam[ch])); float av, bv;
            lru_ab(red[row * 64 + cp + e], red[row * 64 + 32 + cp + e], a->b_rg[ch], a->b_ig[ch], c8, XCF[row * DR_ + ch], av, bv);
            const float hn = av * a->sh[row * DR_ + ch] + bv;
            a->out[O_HS + row * DR_ + ch] = hn;
            HBS[row * DR_ + ch] = (bf16_t)(cvt_pk_bf16(hn * GGS[row * DR_ + ch], 0.f) & 0xffffu); }
    }
};

constexpr int AT_PITCH = 144, AT_VOFF = 384 * AT_PITCH;
typedef short v4i16_t __attribute__((ext_vector_type(4)));
struct AttnRegs { u32x4 kv[6], vv[6]; bf16x8 qf[4]; };
__device__ __forceinline__ void attn_decode(int u, int& g, int& h, int& dsh, int& res, int& qb) { g = u >> 9; h = (u >> 6) & 7; const int rem = u & 63; dsh = 2 * g; res = rem >> (6 - dsh); qb = rem & ((64 >> dsh) - 1); }
__device__ __forceinline__ void attn_issue(int u, const bf16_t* Q, const bf16_t* K, const bf16_t* V, AttnRegs& R) {
    const int tid = threadIdx.x, lane = tid & 63, wid = tid >> 6, r32 = lane & 31, h2 = lane >> 5;
    int g, h, dsh, res, qb; attn_decode(u, g, h, dsh, res, qb);
    const int hc = (8 * g + h) * 64, m0 = 256 * qb - 128;
#pragma unroll
    for (int i = 0; i < 6; ++i) { const int id = tid + 512 * i, key = id >> 3, ch = id & 7, mk = m0 + key;
        R.kv[i] = (u32x4){0u, 0u, 0u, 0u}; R.vv[i] = R.kv[i];
        if (mk >= 0) { const size_t off = (size_t)((mk << dsh) + res) * QKV_ + hc + ch * 8; R.kv[i] = *(const u32x4*)(K + off); R.vv[i] = *(const u32x4*)(V + off); } }
    const int qi = 32 * wid + r32; const size_t tq = (size_t)(((256 * qb + qi) << dsh) + res);
#pragma unroll
    for (int ks = 0; ks < 4; ++ks) R.qf[ks] = *(const bf16x8*)(Q + tq * QKV_ + hc + 16 * ks + 8 * h2);
}
__device__ __forceinline__ void attn_stage(LAS unsigned char* lds, const AttnRegs& R) {
    const int tid = threadIdx.x;
#pragma unroll
    for (int i = 0; i < 6; ++i) { const int id = tid + 512 * i, key = id >> 3, ch = id & 7;
        *(LAS u32x4*)(lds + key * AT_PITCH + ch * 16) = R.kv[i]; *(LAS u32x4*)(lds + AT_VOFF + key * AT_PITCH + ch * 16) = R.vv[i]; }
}
__device__ __forceinline__ void attn_compute(LAS unsigned char* lds, int u, const bf16x8 (&qf)[4], bf16_t* OG, float* ST) {
    const int tid = threadIdx.x, lane = tid & 63, wid = __builtin_amdgcn_readfirstlane(tid >> 6), r32 = lane & 31, h2 = lane >> 5;
    int g, h, dsh, res, qb; attn_decode(u, g, h, dsh, res, qb);
    const int qi = 32 * wid + r32; const size_t tq = (size_t)(((256 * qb + qi) << dsh) + res);
    f32x16 s[5];
#pragma unroll
    for (int kt = 0; kt < 5; ++kt) {
#pragma unroll
        for (int i = 0; i < 16; ++i) s[kt][i] = 0.f;
#pragma unroll
        for (int ks = 0; ks < 4; ++ks) { const bf16x8 kf = *(const LAS bf16x8*)(lds + (32 * wid + 32 * kt + r32) * AT_PITCH + (16 * ks + 8 * h2) * 2);
            s[kt] = __builtin_amdgcn_mfma_f32_32x32x16_bf16(kf, qf[ks], s[kt], 0, 0, 0); }
    }
#pragma unroll
    for (int r = 0; r < 16; ++r) { const int k0 = (r & 3) + 8 * (r >> 2) + 4 * h2; if (k0 < r32) s[0][r] = -1e30f; if (k0 > r32) s[4][r] = -1e30f; }
    if (qb == 0) {
#pragma unroll
        for (int kt = 0; kt < 5; ++kt)
#pragma unroll
            for (int r = 0; r < 16; ++r) { const int kk = 32 * wid + 32 * kt + (r & 3) + 8 * (r >> 2) + 4 * h2; if (kk < 128) s[kt][r] = -1e30f; }
    }
    float mx = -1e30f;
#pragma unroll
    for (int kt = 0; kt < 5; ++kt)
#pragma unroll
        for (int r = 0; r < 16; ++r) mx = fmaxf(mx, s[kt][r]);
    mx = fmaxf(mx, __shfl_xor(mx, 32));
    float den = 0.f;
#pragma unroll
    for (int kt = 0; kt < 5; ++kt)
#pragma unroll
        for (int r = 0; r < 16; ++r) { const float p = __builtin_amdgcn_exp2f(s[kt][r] - mx); s[kt][r] = p; den += p; }
    den += __shfl_xor(den, 32);
    f32x16 o[2];
#pragma unroll
    for (int i = 0; i < 16; ++i) { o[0][i] = 0.f; o[1][i] = 0.f; }
    const LAS unsigned char* vbase = lds + AT_VOFF + (32 * wid + 4 * h2 + ((lane & 15) >> 2)) * AT_PITCH + (16 * ((lane >> 4) & 1) + 4 * (lane & 3)) * 2;
#pragma unroll
    for (int kt = 0; kt < 5; ++kt)
#pragma unroll
        for (int s2 = 0; s2 < 2; ++s2) {
            u32x4 pw; pw.x = cvt_pk_bf16(s[kt][8 * s2 + 0], s[kt][8 * s2 + 1]); pw.y = cvt_pk_bf16(s[kt][8 * s2 + 2], s[kt][8 * s2 + 3]);
            pw.z = cvt_pk_bf16(s[kt][8 * s2 + 4], s[kt][8 * s2 + 5]); pw.w = cvt_pk_bf16(s[kt][8 * s2 + 6], s[kt][8 * s2 + 7]);
            const bf16x8 pb = __builtin_bit_cast(bf16x8, pw);
#pragma unroll
            for (int dt = 0; dt < 2; ++dt) {
                const LAS unsigned char* vp = vbase + (32 * kt + 16 * s2) * AT_PITCH + 64 * dt;
                const v4i16_t lo = __builtin_amdgcn_ds_read_tr16_b64_v4i16((LAS v4i16_t*)vp), hi = __builtin_amdgcn_ds_read_tr16_b64_v4i16((LAS v4i16_t*)(vp + 8 * AT_PITCH));
                const bf16x8 va = (bf16x8){lo[0], lo[1], lo[2], lo[3], hi[0], hi[1], hi[2], hi[3]};
                o[dt] = __builtin_amdgcn_mfma_f32_32x32x16_bf16(va, pb, o[dt], 0, 0, 0);
            }
        }
    const float rden = 1.0f / den;
    bf16_t* orow = OG + ((size_t)g * S_ + tq) * 512 + h * 64 + 4 * h2;
#pragma unroll
    for (int dt = 0; dt < 2; ++dt)
#pragma unroll
        for (int rg = 0; rg < 4; ++rg) { u32x2 w; w.x = cvt_pk_bf16(o[dt][4 * rg] * rden, o[dt][4 * rg + 1] * rden); w.y = cvt_pk_bf16(o[dt][4 * rg + 2] * rden, o[dt][4 * rg + 3] * rden);
            *(u32x2*)(orow + 32 * dt + 8 * rg) = w; }
    if (h2 == 0) *(f32x2*)(ST + (((size_t)g * S_ + tq) * 8 + h) * 2) = (f32x2){mx, den};
}
__device__ __forceinline__ void attn_phase(LAS unsigned char* lds, int blk, int G, const bf16_t* Q, const bf16_t* K, const bf16_t* V, bf16_t* OG, float* ST) {
    AttnRegs R; int u = blk;
    if (u < 1536) attn_issue(u, Q, K, V, R);
    for (; u < 1536; u += G) {
        attn_stage(lds, R);
        bf16x8 qc[4];
#pragma unroll
        for (int ks = 0; ks < 4; ++ks) qc[ks] = R.qf[ks];
        __syncthreads();
        if (u + G < 1536) attn_issue(u + G, Q, K, V, R);
        attn_compute(lds, u, qc, OG, ST);
        __syncthreads();
    }
}
__device__ __forceinline__ void attn_combine(const bf16_t* OG, const float* ST, bf16_t* ATT, int blk, int G) {
    const int gt = blk * NTHREADS + threadIdx.x, NT = G * NTHREADS;
    for (int i0 = gt; i0 < S_ * 64; i0 += 4 * NT) {
        f32x2 st[4][3]; u32x4 og[4][3];
#pragma unroll
        for (int k = 0; k < 4; ++k) { const int i = (i0 + k * NT) < S_ * 64 ? (i0 + k * NT) : i0; const int t = i >> 6, h = (i >> 3) & 7, c8 = i & 7;
#pragma unroll
            for (int g = 0; g < 3; ++g) { st[k][g] = *(const f32x2*)(ST + (((size_t)g * S_ + t) * 8 + h) * 2); og[k][g] = *(const u32x4*)(OG + ((size_t)g * S_ + t) * 512 + h * 64 + c8 * 8); } }
#pragma unroll
        for (int k = 0; k < 4; ++k) { const int i = i0 + k * NT; if (i < S_ * 64) { const int t = i >> 6, h = (i >> 3) & 7, c8 = i & 7;
            const float M = fmaxf(st[k][0][0], fmaxf(st[k][1][0], st[k][2][0]));
            float w[3], wsum = 0.f;
#pragma unroll
            for (int g = 0; g < 3; ++g) { w[g] = st[k][g][1] * __builtin_amdgcn_exp2f(st[k][g][0] - M); wsum += w[g]; }
            const float rw = 1.0f / wsum;
            f32x4 a0 = (f32x4){0.f, 0.f, 0.f, 0.f}, a1 = a0;
#pragma unroll
            for (int g = 0; g < 3; ++g) { f32x4 x0, x1; unpack8(og[k][g], x0, x1); a0 += x0 * (w[g] * rw); a1 += x1 * (w[g] * rw); }
            *(u32x4*)(ATT + (size_t)t * KCAT_ + h * 64 + c8 * 8) = pack8(a0, a1); } }
    }
}

constexpr int XC_PITCH = 136;
struct RnnRegs { u32x4 xr[7]; };
__device__ __forceinline__ void rnn_issue(int u, const bf16_t* XB, const bf16_t* GG, RnnRegs& R) {
    const int tid = threadIdx.x; const int c = u / 10, n = u - 10 * c;
    const int co = tid & 15, tg = tid >> 4, ch0 = n * 128 + 8 * co, t0 = 128 * c + 4 * tg;
#pragma unroll
    for (int i = 0; i < 7; ++i) { const int tt = t0 - 3 + i; R.xr[i] = (u32x4){0u, 0u, 0u, 0u}; if (tt >= 0) R.xr[i] = *(const u32x4*)(XB + (size_t)tt * DR_ + ch0); }
}
__device__ __forceinline__ void rnn_unit(LAS unsigned char* lds, int u, int unext, const Args& a, const bf16_t* XB, const bf16_t* GG, const bf16_t* WG, float* AGG, bf16_t* HLG, bf16_t* PCG, RnnRegs& R) {
    const int tid = threadIdx.x, lane = tid & 63, wid = __builtin_amdgcn_readfirstlane(tid >> 6), r32 = lane & 31, h2 = lane >> 5;
    const int c = u / 10, n = u - 10 * c;
    LAS float* A_s = (LAS float*)lds; LAS float* B_s = A_s + 16384; LAS bf16_t* XC = (LAS bf16_t*)lds;
    LAS f32x2* SEG = (LAS f32x2*)(lds + MISC_OFF);
    const int cwv = wid & 3, rh = wid >> 2;
    bf16x8 wfr[8], wfi[8];
    {   const bf16_t* wrp = WG + (size_t)(n * 256 + 32 * cwv + r32) * 128 + 8 * h2; const bf16_t* wip = wrp + 128 * 128;
#pragma unroll
        for (int ks = 0; ks < 8; ++ks) { wfr[ks] = *(const bf16x8*)(wrp + 16 * ks); wfi[ks] = *(const bf16x8*)(wip + 16 * ks); } }
    {
        const int co = tid & 15, tg = tid >> 4, ch0 = n * 128 + 8 * co;
        f32x4 cw[4][2], cb[2];
#pragma unroll
        for (int j = 0; j < 4; ++j) { cw[j][0] = *(const f32x4*)(a.convw + j * DR_ + ch0); cw[j][1] = *(const f32x4*)(a.convw + j * DR_ + ch0 + 4); }
        cb[0] = *(const f32x4*)(a.convb + ch0); cb[1] = *(const f32x4*)(a.convb + ch0 + 4);
        f32x4 x[7][2];
#pragma unroll
        for (int i = 0; i < 7; ++i) unpack8(R.xr[i], x[i][0], x[i][1]);
#pragma unroll
        for (int k = 0; k < 4; ++k) { f32x4 y0 = cb[0], y1 = cb[1];
#pragma unroll
            for (int j = 0; j < 4; ++j) { y0 += cw[j][0] * x[k + j][0]; y1 += cw[j][1] * x[k + j][1]; }
            *(LAS u32x4*)(XC + (4 * tg + k) * XC_PITCH + 8 * co) = pack8(y0, y1); }
    }
    __syncthreads();
    f32x16 ar[2], ai[2];
#pragma unroll
    for (int i = 0; i < 16; ++i) { ar[0][i] = 0.f; ar[1][i] = 0.f; ai[0][i] = 0.f; ai[1][i] = 0.f; }
#pragma unroll
    for (int ks = 0; ks < 8; ++ks) {
#pragma unroll
        for (int rt = 0; rt < 2; ++rt) { const bf16x8 av = *(const LAS bf16x8*)(XC + (64 * rh + 32 * rt + r32) * XC_PITCH + 16 * ks + 8 * h2);
            ar[rt] = __builtin_amdgcn_mfma_f32_32x32x16_bf16(av, wfr[ks], ar[rt], 0, 0, 0); ai[rt] = __builtin_amdgcn_mfma_f32_32x32x16_bf16(av, wfi[ks], ai[rt], 0, 0, 0); } }
    if (unext < 1280) rnn_issue(unext, XB, GG, R);
    u32x4 ggv[4];
#pragma unroll
    for (int i = 0; i < 4; ++i) { const int item = tid + 512 * i, t = item >> 4, c8i = item & 15; ggv[i] = *(const u32x4*)(GG + (size_t)(128 * c + t) * DR_ + n * 128 + 8 * c8i); }
    {   const int chl = 32 * cwv + r32, chg = n * 128 + chl;
        const float brg = a.b_rg[chg], big = a.b_ig[chg], c8 = -8.0f * log1pf(expf(-a.lam[chg]));
#pragma unroll
        for (int rt = 0; rt < 2; ++rt)
#pragma unroll
            for (int r = 0; r < 16; ++r) { const int tl = 64 * rh + 32 * rt + (r & 3) + 8 * (r >> 2) + 4 * h2;
                const float xcv = bf2f(XC[tl * XC_PITCH + chl]);
                float av, bv; lru_ab(ar[rt][r], ai[rt][r], brg, big, c8, xcv, av, bv); ar[rt][r] = av; ai[rt][r] = bv; }
        __syncthreads();
#pragma unroll
        for (int rt = 0; rt < 2; ++rt)
#pragma unroll
            for (int r = 0; r < 16; ++r) { const int tl = 64 * rh + 32 * rt + (r & 3) + 8 * (r >> 2) + 4 * h2; A_s[tl * 128 + chl] = ar[rt][r]; B_s[tl * 128 + chl] = ai[rt][r]; }
    }
    __syncthreads();
    {   const int ch = tid & 127, seg = tid >> 7;
        float Ap = 1.f, Bp = 0.f;
#pragma unroll 8
        for (int k = 0; k < 32; ++k) { const float av = A_s[(32 * seg + k) * 128 + ch], bv = B_s[(32 * seg + k) * 128 + ch]; Bp = av * Bp + bv; Ap *= av; }
        SEG[seg * 128 + ch] = (f32x2){Ap, Bp};
        __syncthreads();
        float hcur = 0.f, pcur = 1.f;
        for (int q = 0; q < seg; ++q) { const f32x2 sg = SEG[q * 128 + ch]; hcur = sg[0] * hcur + sg[1]; pcur *= sg[0]; }
#pragma unroll 8
        for (int k = 0; k < 32; ++k) { const int idx = (32 * seg + k) * 128 + ch; const float av = A_s[idx], bv = B_s[idx]; hcur = av * hcur + bv; pcur *= av; A_s[idx] = pcur; B_s[idx] = hcur; }
        if (seg == 3) *(f32x2*)(AGG + ((size_t)c * DR_ + n * 128 + ch) * 2) = (f32x2){pcur, hcur};
    }
    __syncthreads();
#pragma unroll
    for (int i = 0; i < 4; ++i) { const int item = tid + 512 * i, t = item >> 4, c8i = item & 15;
        const f32x4 p0 = *(const LAS f32x4*)(A_s + t * 128 + 8 * c8i), p1 = *(const LAS f32x4*)(A_s + t * 128 + 8 * c8i + 4);
        const f32x4 h0 = *(const LAS f32x4*)(B_s + t * 128 + 8 * c8i), h1 = *(const LAS f32x4*)(B_s + t * 128 + 8 * c8i + 4);
        f32x4 g0, g1; unpack8(ggv[i], g0, g1);
        const size_t off = (size_t)(128 * c + t) * DR_ + n * 128 + 8 * c8i;
        *(u32x4*)(HLG + off) = pack8(h0 * g0, h1 * g1); *(u32x4*)(PCG + off) = pack8(p0 * g0, p1 * g1); }
    __syncthreads();
}
__device__ __forceinline__ void rnn_fix_phase(LAS unsigned char* lds, int blk, int G, const Args& a, const float* AGG, const bf16_t* HLG, const bf16_t* PCG, bf16_t* HB) {
    const int tid = threadIdx.x;
    LAS f32x2* CAR = (LAS f32x2*)lds; LAS float* HIN = (LAS float*)(lds + 32768);
    for (int ub = blk; ub < 1280; ub += 5 * G) {
        {   const int ch = tid & 127, q = tid >> 7;
#pragma unroll
            for (int i = 0; i < 5; ++i) { const int u = ub + i * G; if (u < 1280) { const int c = u / 10, n = u - 10 * c, lo = (c * q) >> 2, hi = (c * (q + 1)) >> 2;
                float Ap = 1.f, Bp = 0.f;
#pragma unroll 4
                for (int k = lo; k < hi; ++k) { const f32x2 ab = *(const f32x2*)(AGG + ((size_t)k * DR_ + n * 128 + ch) * 2); Bp = ab[0] * Bp + ab[1]; Ap *= ab[0]; }
                CAR[(i * 4 + q) * 128 + ch] = (f32x2){Ap, Bp}; } }
        }
        __syncthreads();
        for (int j = tid; j < 5 * 128; j += NTHREADS) { const int i = j >> 7, ch = j & 127, u = ub + i * G;
            if (u < 1280) { const int c = u / 10, n = u - 10 * c; float hin = 0.f;
#pragma unroll
                for (int q = 0; q < 4; ++q) { const f32x2 cg = CAR[(i * 4 + q) * 128 + ch]; hin = cg[0] * hin + cg[1]; }
                HIN[j] = hin;
                if (c == 127) { const f32x2 ab = *(const f32x2*)(AGG + ((size_t)127 * DR_ + n * 128 + ch) * 2); a.out[O_HP + n * 128 + ch] = ab[0] * hin + ab[1]; } } }
        __syncthreads();
#pragma unroll 1
        for (int i = 0; i < 5; ++i) { const int u = ub + i * G; if (u >= 1280) break; const int c = u / 10, n = u - 10 * c;
            u32x4 hv[4], pv[4];
#pragma unroll
            for (int k = 0; k < 4; ++k) { const int item = tid + 512 * k, t = item >> 4, c8i = item & 15; const size_t off = (size_t)(128 * c + t) * DR_ + n * 128 + 8 * c8i;
                hv[k] = *(const u32x4*)(HLG + off); pv[k] = *(const u32x4*)(PCG + off); }
#pragma unroll
            for (int k = 0; k < 4; ++k) { const int item = tid + 512 * k, t = item >> 4, c8i = item & 15;
                const f32x4 i0 = *(const LAS f32x4*)(HIN + i * 128 + 8 * c8i), i1 = *(const LAS f32x4*)(HIN + i * 128 + 8 * c8i + 4);
                f32x4 h0, h1, p0, p1; unpack8(hv[k], h0, h1); unpack8(pv[k], p0, p1);
                *(u32x4*)(HB + (size_t)(128 * c + t) * KCAT_ + 512 + n * 128 + 8 * c8i) = pack8(h0 + p0 * i0, h1 + p1 * i1); } }
        __syncthreads();
    }
}

__device__ __forceinline__ void sample_attn_item(int it, const Args& a, const float* QS, float* OGS, float* STS) {
    const int lane = threadIdx.x & 63;
    const int sp = it & 3, bgh = it >> 2, b = bgh / 24, gh = bgh - 24 * b, g = gh >> 3, h = gh & 7;
    const int L = 128 << (2 * g), d = 1 << (2 * g), j0 = 33 * sp;
    const float* cache = (g == 0 ? a.c128 : (g == 1 ? a.c512 : a.c2048)) + (size_t)b * L * 1024 + h * 64;
    const float* knew = a.out + (g == 0 ? O_KVS0 : (g == 1 ? O_KVS1 : O_KVS2)) + (size_t)b * 1024 + h * 64;
    const int ks = lane >> 2, part = lane & 3;
    f32x4 q[4];
#pragma unroll
    for (int i = 0; i < 4; ++i) q[i] = *(const f32x4*)(QS + b * QKV_ + (8 * g + h) * 64 + 16 * part + 4 * i);
    float sc[3]; float mx = -1e30f;
#pragma unroll
    for (int i3 = 0; i3 < 3; ++i3) {
        const int jl = 16 * i3 + ks, j = j0 + jl; const bool valid = jl < 33 && j <= 128; const int jj = valid ? j : j0 + 1;
        const float* kp = (jj == 0) ? knew : cache + (size_t)(L - d * jj) * 1024;
        float dot = 0.f;
#pragma unroll
        for (int i = 0; i < 4; ++i) { const f32x4 kv = *(const f32x4*)(kp + 16 * part + 4 * i); dot += (q[i][0] * kv[0] + q[i][1] * kv[1]) + (q[i][2] * kv[2] + q[i][3] * kv[3]); }
        dot += __shfl_xor(dot, 1); dot += __shfl_xor(dot, 2);
        sc[i3] = valid ? dot : -1e30f; mx = fmaxf(mx, sc[i3]);
    }
    mx = fmaxf(mx, __shfl_xor(mx, 4)); mx = fmaxf(mx, __shfl_xor(mx, 8)); mx = fmaxf(mx, __shfl_xor(mx, 16)); mx = fmaxf(mx, __shfl_xor(mx, 32));
    float den = 0.f;
#pragma unroll
    for (int i3 = 0; i3 < 3; ++i3) { sc[i3] = __builtin_amdgcn_exp2f(sc[i3] - mx); den += sc[i3]; }
    den += __shfl_xor(den, 4); den += __shfl_xor(den, 8); den += __shfl_xor(den, 16); den += __shfl_xor(den, 32);
    const int kq = lane >> 4, dq = lane & 15;
    f32x4 acc = (f32x4){0.f, 0.f, 0.f, 0.f};
#pragma unroll
    for (int i2 = 0; i2 < 9; ++i2) {
        const int jl = 4 * i2 + kq, j = j0 + jl; const bool valid = jl < 33 && j <= 128; const int jj = valid ? j : j0 + 1;
        float p = __shfl(sc[i2 >> 2], (jl & 15) << 2); if (!valid) p = 0.f;
        const float* vp = ((jj == 0) ? knew : cache + (size_t)(L - d * jj) * 1024) + 512;
        const f32x4 vv = *(const f32x4*)(vp + 4 * dq);
        acc += vv * p;
    }
#pragma unroll
    for (int e = 0; e < 4; ++e) { acc[e] += __shfl_xor(acc[e], 16); acc[e] += __shfl_xor(acc[e], 32); }
    const int pi = (b * 12 + g * 4 + sp);
    if (kq == 0) *(f32x4*)(OGS + pi * 512 + h * 64 + 4 * dq) = acc * (1.0f / den);
    if (lane == 0) *(f32x2*)(STS + (pi * 8 + h) * 2) = (f32x2){mx, den};
}
__device__ __forceinline__ void sample_combine(const float* OGS, const float* STS, bf16_t* ATTS, int blk) {
    const int i = blk * NTHREADS + threadIdx.x;
    if (i < NBS * 512) { const int b = i >> 9, cidx = i & 511, h = cidx >> 6;
        f32x2 st[12]; float M = -1e30f;
#pragma unroll
        for (int p = 0; p < 12; ++p) { st[p] = *(const f32x2*)(STS + ((b * 12 + p) * 8 + h) * 2); M = fmaxf(M, st[p][0]); }
        float num = 0.f, wsum = 0.f;
#pragma unroll
        for (int p = 0; p < 12; ++p) { const float w = st[p][1] * __builtin_amdgcn_exp2f(st[p][0] - M); wsum += w; num += w * OGS[(b * 12 + p) * 512 + cidx]; }
        ATTS[b * 512 + cidx] = (bf16_t)(cvt_pk_bf16(num / wsum, 0.f) & 0xffffu); }
}

__global__ void __launch_bounds__(NTHREADS, 2) fwd_mega(Args a) {
    extern __shared__ __attribute__((aligned(16))) unsigned char lds_raw[];
    LAS unsigned char* lds = (LAS unsigned char*)lds_raw;
    cg::grid_group grid = cg::this_grid();
    const int G = gridDim.x, blk = blockIdx.x, tid = threadIdx.x, wid = tid >> 6;
    unsigned char* ws = a.ws; float* out = a.out;
    bf16_t *WIN = (bf16_t*)(ws + WS_WIN), *WG = (bf16_t*)(ws + WS_WG), *WOA = (bf16_t*)(ws + WS_WOA), *WOB = (bf16_t*)(ws + WS_WOB), *WOUT = (bf16_t*)(ws + WS_WOUT), *WF1 = (bf16_t*)(ws + WS_WFF1), *WF2 = (bf16_t*)(ws + WS_WFF2);
    bf16_t *HN = (bf16_t*)(ws + WS_HN), *Qb = (bf16_t*)(ws + WS_Q), *Kb = (bf16_t*)(ws + WS_K), *Vb = (bf16_t*)(ws + WS_V), *XB = (bf16_t*)(ws + WS_XB), *GG = (bf16_t*)(ws + WS_GG), *SA = (bf16_t*)(ws + WS_SA), *SB = (bf16_t*)(ws + WS_SB);
    bf16_t *TMP = (bf16_t*)(ws + WS_TMP), *OG = (bf16_t*)(ws + WS_OG), *ATT = (bf16_t*)(ws + WS_ATT), *HB = (bf16_t*)(ws + WS_HB), *MRG = (bf16_t*)(ws + WS_MRG), *A2 = (bf16_t*)(ws + WS_A2), *HID = (bf16_t*)(ws + WS_HID);
    float *ST = (float*)(ws + WS_ST), *AGG = (float*)(ws + WS_AGG),  *SSQ = (float*)(ws + WS_SSQ);
    unsigned char* sm = ws + WS_SMALL;
    float *QS = (float*)(sm + SM_QS * SM_STRIDE), *XBS = (float*)(sm + SM_XBS * SM_STRIDE), *GGS = (float*)(sm + SM_GGS * SM_STRIDE), *SAS = (float*)(sm + SM_SAS * SM_STRIDE), *SBS = (float*)(sm + SM_SBS * SM_STRIDE);
    float *OGS = (float*)(sm + SM_N * SM_STRIDE), *XCF = (float*)(sm + SM_XCF * SM_STRIDE), *STS = (float*)(sm + SM_STS * SM_STRIDE), *TMPS = (float*)(sm + SM_TMPS * SM_STRIDE), *X1S = (float*)(sm + SM_X1S * SM_STRIDE), *SSQS = (float*)(sm + SM_SSQS * SM_STRIDE);
    bf16_t *XCS = (bf16_t*)(sm + SM_XCS * SM_STRIDE), *ATTS = (bf16_t*)(sm + SM_ATTS * SM_STRIDE), *HBS = (bf16_t*)(sm + SM_HBS * SM_STRIDE), *MRGS = (bf16_t*)(sm + SM_MRGS * SM_STRIDE), *A2S = (bf16_t*)(sm + SM_A2S * SM_STRIDE), *HIDS = (bf16_t*)(sm + SM_HIDS * SM_STRIDE);
    bf16_t* HNS = HN + (size_t)S_ * DM_;
    bf16_t *ACAT = Qb, *WCAT = WOA;
    bf16_t *HLG = (bf16_t*)(ws + WS_TMP), *PCG = (bf16_t*)(ws + WS_HID);
    const int lo = a.ph_lo, hi = a.ph_hi;
#define IN(k) (lo <= (k) && (k) < hi)
#define SEAM(k) do { if (IN(k) && IN((k) + 1)) xcd_barrier(bar); } while (0)
    if (tid < 4) ((LAS unsigned*)(lds + MISC_OFF + 12288))[tid] = 0u;
    __syncthreads();
    XcdBarrier bar = xcd_barrier_post((unsigned*)(ws + WS_CTL), (volatile LAS unsigned*)(lds + MISC_OFF + 12288));
    if (a.ph_hi > 1000) grid.sync();

    if (IN(0)) { p0_prologue<0>(a, lds, blk, G); }
    SEAM(0);
    if (IN(1)) {
        { SEpiIn E{&a, QS, XBS, GGS, SAS, SBS, XCS, XCF}; small_gemm<DM_, 8>(lds, HNS, DM_, WIN, DM_, 144, G, blk, E); }
        pg8::Gemm g{HN, WIN, S_, INW_, DM_, DM_}; pg8::StaticOrder S; S.init(S_, INW_, G, blk);
        pg8::EpiIn E{Qb, Kb, Vb, XB, GG, SA, SB, out, a.qg, a.kg, a.bgate};
        pg8::gemm_phase<pg8::EpiIn, pg8::StaticOrder, true, true>(lds, g, S, E);
    }
    SEAM(1);
    if (IN(2)) {
        const int gw = blk * NWAVES + wid, NGW = G * NWAVES;
        p0_prologue<1>(a, lds, blk, G); __syncthreads();
        { SEpiRnn E{&a, XCF, GGS, HBS}; small_gemm<128, 1>(lds, XCS, DR_, WG, 128, 40, G, blk, E); }
        for (int it = gw; it < NBS * 24 * 4; it += NGW) sample_attn_item(it, a, QS, OGS, STS);
        __syncthreads();
        attn_phase(lds, blk, G, Qb, Kb, Vb, OG, ST);
        { RnnRegs R; if (blk < 1280) rnn_issue(blk, XB, GG, R);
          for (int u = blk; u < 1280; u += G) rnn_unit(lds, u, u + G, a, XB, GG, WG, AGG, HLG, PCG, R); }
    }
    SEAM(2);
    if (IN(3)) {
        sample_combine(OGS, STS, ATTS, blk);
        rnn_fix_phase(lds, blk, G, a, AGG, HLG, PCG, ACAT);
        attn_combine(OG, ST, ACAT, blk, G);
    }
    SEAM(3);
    if (IN(4)) {
        { SEpiYa E{SAS, TMPS}; small_gemm<512, 4>(lds, ATTS, 512, WCAT, KCAT_, 16, G, blk, E); }
        { SEpiYb E{SBS, TMPS, MRGS}; small_gemm<DR_, 10>(lds, HBS, DR_, WCAT + 512, KCAT_, 16, G, blk, E); }
        { pg8::Gemm g{ACAT, WCAT, S_, DM_, KCAT_, KCAT_}; pg8::StaticOrder S; S.init(S_, DM_, G, blk); pg8::EpiMrg E{SA, SB, MRG};
          pg8::gemm_phase<pg8::EpiMrg, pg8::StaticOrder, true, true, 8>(lds, g, S, E); }
    }
    SEAM(4);
    if (IN(5)) {
        { SEpiWout E{a.xs, a.n2g, X1S, A2S, SSQS}; small_gemm<DM_, 8>(lds, MRGS, DM_, WOUT, DM_, 16, G, blk, E); }
        pg8::Gemm g{MRG, WOUT, S_, DM_, DM_, DM_}; pg8::StaticOrder S; S.init(S_, DM_, G, blk); pg8::EpiWout E{a.x, out + O_YP, A2, SSQ, a.n2g};
        pg8::gemm_phase<pg8::EpiWout, pg8::StaticOrder, true, true>(lds, g, S, E);
    }
    SEAM(5);
    if (IN(6)) {
        { SEpiFfn1 E{SSQS, HIDS}; small_gemm<DM_, 8>(lds, A2S, DM_, WF1, DM_, 88, G, blk, E); }
        pg8::Gemm g{A2, WF1, S_, 2 * DFF_, DM_, DM_}; pg8::StaticOrder S; S.init(S_, 2 * DFF_, G, blk); pg8::EpiFfn1 E{SSQ, HID};
        pg8::gemm_phase<pg8::EpiFfn1, pg8::StaticOrder, true, true>(lds, g, S, E);
    }
    SEAM(6);
    if (IN(7)) {
        { SEpiOut E{X1S, out + O_YS}; small_gemm<DFF_, 11>(lds, HIDS, DFF_, WF2, LDH_, 16, G, blk, E); }
        pg8::Gemm g{HID, WF2, S_, DM_, DFF_, LDH_}; pg8::StaticOrder S; S.init(S_, DM_, G, blk); pg8::EpiOut E{out + O_YP};
        pg8::gemm_phase<pg8::EpiOut, pg8::StaticOrder, true, true>(lds, g, S, E);
    }
#undef IN
#undef SEAM
}

extern "C" void kernel_launch(void* const* d_in, const int* in_sizes, int n_in, void* d_out, int out_size, void* d_ws, size_t ws_size, hipStream_t stream) {
    static int grid = 0;
    if (grid == 0) {
        if (n_in != 25 || in_sizes[0] != S_ * DM_ || (size_t)out_size != O_END || ws_size < WS_END) {
            fprintf(stderr, "kernel_launch: unexpected shapes: n_in %d in0 %d out %d ws %zu (need >= %zu); nothing launched\n", n_in, n_in > 0 ? in_sizes[0] : -1, out_size, ws_size, (size_t)WS_END); grid = -1; return; }
        int dev = 0, cus = 0, per_cu = 0;
        if (hipGetDevice(&dev) != hipSuccess || hipDeviceGetAttribute(&cus, hipDeviceAttributeMultiprocessorCount, dev) != hipSuccess) { grid = -1; return; }
        if (hipFuncSetAttribute((const void*)fwd_mega, hipFuncAttributeMaxDynamicSharedMemorySize, LDS_BYTES) != hipSuccess) { fprintf(stderr, "kernel_launch: hipFuncSetAttribute failed\n"); grid = -1; return; }
        if (hipOccupancyMaxActiveBlocksPerMultiprocessor(&per_cu, (const void*)fwd_mega, NTHREADS, LDS_BYTES) != hipSuccess || per_cu < 1) { fprintf(stderr, "kernel_launch: occupancy query says %d blocks per CU\n", per_cu); per_cu = 1; }
        (void)hipGetLastError();
        grid = cus * per_cu;
    }
    if (grid < 0) return;
    if (hipMemsetAsync((char*)d_ws + WS_CTL, 0, CTL_ZERO_BYTES, stream) != hipSuccess) { fprintf(stderr, "kernel_launch: memset failed\n"); return; }
    Args a{};
    const float** f = (const float**)&a;
    for (int i = 0; i < 25; ++i) f[i] = (const float*)d_in[i];
    a.out = (float*)d_out; a.ws = (unsigned char*)d_ws;
#if MK_MULTI
    for (int p = 0; p < 8; ++p) { a.ph_lo = p; a.ph_hi = p + 1; hipLaunchKernelGGL(fwd_mega, dim3(grid), dim3(NTHREADS), LDS_BYTES, stream, a); }
#else
    a.ph_lo = 0; a.ph_hi = 8;
    void* args[] = {&a};
    const hipError_t e = hipLaunchCooperativeKernel((const void*)fwd_mega, dim3(grid), dim3(NTHREADS), args, LDS_BYTES, stream);
    if (e != hipSuccess) fprintf(stderr, "kernel_launch: cooperative launch failed: %s (grid %d)\n", hipGetErrorString(e), grid);
#endif
}
```
